# Optimizing an MI355X kernel written in HIP

```python
import math
import jax, jax.numpy as jnp
from jax import lax
import numpy as np

D_MODEL = 1024
BATCH = 8
SEQ = 4096
DEPTH = 4

HEAD_DIM = 64
N_HEADS = 8
N_KV_HEADS = 2
WINDOW = 128
ATTN_WIDTH = N_HEADS * HEAD_DIM
KV_WIDTH = N_KV_HEADS * HEAD_DIM
CONV_CH = D_MODEL // 2
CONV_WIDTH = 31
MIX_WIDTH = ATTN_WIDTH + CONV_CH
IN_WIDTH = ATTN_WIDTH + 2 * KV_WIDTH + 2 * CONV_CH
D_FF = 2816
FFN_RESIDUAL_WEIGHT = 0.5
EPS = 1e-6
NEG_INF = -1e30

kernel_name = "hybrid_swa_sink_alibi_conformer_conv_macaron"


def rms_norm(x, g):
    xf = x.astype(jnp.float32)
    y = xf * lax.rsqrt(jnp.mean(xf * xf, axis=-1, keepdims=True) + EPS)
    return (y * g.astype(jnp.float32)).astype(x.dtype)


def swiglu_ffn(h, w_in, w_out):
    gu = h @ w_in
    gate, up = jnp.split(gu, 2, axis=-1)
    return (jax.nn.silu(gate) * up) @ w_out


def alibi_slopes(n_heads):
    return jnp.exp2(-8.0 * jnp.arange(1, n_heads + 1, dtype=jnp.float32) / n_heads)


def sliding_window_sink_attention(q, k, v, sinks):
    B, S, H, hd = q.shape
    nb = S // WINDOW
    G = H // N_KV_HEADS
    qb = q.reshape(B, nb, WINDOW, N_KV_HEADS, G, hd).astype(jnp.float32)

    def band(t):
        cur = t.reshape(B, nb, WINDOW, N_KV_HEADS, hd)
        prev = jnp.pad(cur, ((0, 0), (1, 0), (0, 0), (0, 0), (0, 0)))[:, :-1]
        return jnp.concatenate([prev, cur], axis=2).astype(jnp.float32)

    kb, vb = band(k), band(v)
    scores = jnp.einsum('bnqkgd,bnskd->bkgnqs', qb, kb) * (1.0 / math.sqrt(hd))

    t_loc = jnp.arange(WINDOW)[:, None]
    s_loc = jnp.arange(2 * WINDOW)[None, :]
    dist = t_loc + WINDOW - s_loc
    in_window = (dist >= 0) & (dist < WINDOW)
    blk = jnp.arange(nb)[:, None, None]
    valid = in_window[None] & ((blk > 0) | (s_loc >= WINDOW)[None])

    slopes = alibi_slopes(H).reshape(N_KV_HEADS, G)
    bias = -slopes[:, :, None, None] * jnp.abs(dist).astype(jnp.float32)[None, None]
    scores = jnp.where(valid[None, None, None], scores + bias[:, :, None], NEG_INF)

    sink = sinks.astype(jnp.float32).reshape(N_KV_HEADS, G)[None, :, :, None, None]
    m = jnp.maximum(jnp.max(scores, axis=-1), sink)
    p = jnp.exp(scores - m[..., None])
    denom = jnp.sum(p, axis=-1) + jnp.exp(sink - m)
    p = p / denom[..., None]
    out = jnp.einsum('bkgnqs,bnskd->bnqkgd', p, vb)
    return out.reshape(B, S, H * hd).astype(q.dtype)


def conformer_conv(u, w_dw, b_dw, ln_g, ln_b):
    a, gate = jnp.split(u, 2, axis=-1)
    z = a * jax.nn.sigmoid(gate)
    C = z.shape[-1]
    y = lax.conv_general_dilated(
        z, w_dw.astype(z.dtype)[:, None, :],
        window_strides=(1,), padding=[(CONV_WIDTH - 1, 0)],
        dimension_numbers=('NWC', 'WIO', 'NWC'), feature_group_count=C)
    y = (y + b_dw).astype(jnp.float32)
    mu = jnp.mean(y, axis=-1, keepdims=True)
    var = jnp.mean(jnp.square(y - mu), axis=-1, keepdims=True)
    y = (y - mu) * lax.rsqrt(var + EPS) * ln_g.astype(jnp.float32) + ln_b.astype(jnp.float32)
    return jax.nn.silu(y).astype(u.dtype)


def setup_inputs(seed: int = 0) -> dict:
    key = jax.random.key(seed)
    ks = jax.random.split(key, 20)
    f32 = jnp.float32

    def nrm(k, shape, scale):
        return jax.random.normal(k, shape, f32) * scale

    def gain(k, shape):
        return 1.0 + 0.05 * jax.random.normal(k, shape, f32)

    return {
        "x": jax.random.normal(ks[0], (BATCH, SEQ, D_MODEL), f32),
        "norm_ffn1": gain(ks[1], (DEPTH, D_MODEL)),
        "w_ffn1_in": nrm(ks[2], (DEPTH, D_MODEL, 2 * D_FF), D_MODEL ** -0.5),
        "w_ffn1_out": nrm(ks[3], (DEPTH, D_FF, D_MODEL), D_FF ** -0.5),
        "norm_mix": gain(ks[4], (DEPTH, D_MODEL)),
        "w_in": nrm(ks[5], (DEPTH, D_MODEL, IN_WIDTH), D_MODEL ** -0.5),
        "sinks": nrm(ks[6], (DEPTH, N_HEADS), 1.0),
        "w_dw": nrm(ks[7], (DEPTH, CONV_WIDTH, CONV_CH), CONV_WIDTH ** -0.5),
        "b_dw": nrm(ks[8], (DEPTH, CONV_CH), 0.02),
        "conv_ln_g": gain(ks[9], (DEPTH, CONV_CH)),
        "conv_ln_b": nrm(ks[10], (DEPTH, CONV_CH), 0.02),
        "w_out": nrm(ks[11], (DEPTH, MIX_WIDTH, D_MODEL), MIX_WIDTH ** -0.5),
        "norm_ffn2": gain(ks[12], (DEPTH, D_MODEL)),
        "w_ffn2_in": nrm(ks[13], (DEPTH, D_MODEL, 2 * D_FF), D_MODEL ** -0.5),
        "w_ffn2_out": nrm(ks[14], (DEPTH, D_FF, D_MODEL), D_FF ** -0.5),
        "final_norm": gain(ks[15], (D_MODEL,)),
    }


def reference(x, norm_ffn1, w_ffn1_in, w_ffn1_out, norm_mix, w_in, sinks, w_dw, b_dw,
              conv_ln_g, conv_ln_b, w_out, norm_ffn2, w_ffn2_in, w_ffn2_out, final_norm):
    B, S, _ = x.shape
    split_pts = [ATTN_WIDTH, ATTN_WIDTH + KV_WIDTH, ATTN_WIDTH + 2 * KV_WIDTH]
    for l in range(DEPTH):
        h = rms_norm(x, norm_ffn1[l])
        x = x + FFN_RESIDUAL_WEIGHT * swiglu_ffn(h, w_ffn1_in[l], w_ffn1_out[l])

        h = rms_norm(x, norm_mix[l])
        proj = h @ w_in[l]
        q, k, v, u = jnp.split(proj, split_pts, axis=-1)
        attn = sliding_window_sink_attention(
            q.reshape(B, S, N_HEADS, HEAD_DIM),
            k.reshape(B, S, N_KV_HEADS, HEAD_DIM),
            v.reshape(B, S, N_KV_HEADS, HEAD_DIM),
            sinks[l])
        conv = conformer_conv(u, w_dw[l], b_dw[l], conv_ln_g[l], conv_ln_b[l])
        x = x + jnp.concatenate([attn, conv], axis=-1) @ w_out[l]

        h = rms_norm(x, norm_ffn2[l])
        x = x + FFN_RESIDUAL_WEIGHT * swiglu_ffn(h, w_ffn2_in[l], w_ffn2_out[l])
    return rms_norm(x, final_norm)
```

```cpp
#include <hip/hip_runtime.h>
#include <hip/hip_cooperative_groups.h>
#include <cstdio>
#include <cstdint>
namespace cg = cooperative_groups;
namespace pg8 {
#define PG8_LAS __attribute__((address_space(3)))
typedef unsigned short bf16_t;
typedef short bf16x8 __attribute__((ext_vector_type(8)));
typedef float f32x4 __attribute__((ext_vector_type(4)));
typedef unsigned u32x4 __attribute__((ext_vector_type(4)));
constexpr int BM = 256, BK = 64, HALF = 128, HTB = HALF * BK * 2  , STAGE_BYTES = 8 * HTB, NXCD = 8, WGM = 4;

__host__ __device__ __forceinline__ int lds_byte(int r, int c) { const int st = (r >> 4) * 2 + (c >> 5), rr = r & 15, cc = c & 31, ob = rr * 64 + cc * 2; return st * 1024 + (ob ^ (((ob >> 9) & 1) << 5)); }
__host__ __device__ __forceinline__ void stage_rc(int b, int& R, int& C) { const int st = b / 1024, sb = b % 1024, swz = sb ^ (((sb >> 9) & 1) << 5); R = (st >> 1) * 16 + swz / 64; C = (st & 1) * 32 + (swz % 64) / 2; }
__host__ __device__ __forceinline__ int perm32(int rho) { const int n = rho >> 4, i = rho & 15; return 8 * (i >> 2) + 4 * n + (i & 3); }

struct Unit { int pm, pn; };
struct Gemm { const bf16_t* A; const bf16_t* Bt; int M, N, K; };

struct StaticOrder {
    int nM, nN, nwg, G, c, rep;
    __host__ __device__ void init(int M, int N, int G_, int c_, int rep_ = 1) { nM = M / BM; nN = N / BM; nwg = nM * nN; G = G_; c = c_; rep = rep_; }
    __host__ __device__ bool next(int i, Unit& u) const {
        const int R = (nwg + G - 1) / G; if (i >= R * rep) return false; i = i % R;
        const long L = (long)i * G + c; if (L >= nwg) return false;
        int wgid = (int)L; { const int q = nwg / NXCD, r = nwg % NXCD, xcd = wgid % NXCD, off = wgid / NXCD; wgid = (xcd < r ? xcd * (q + 1) : r * (q + 1) + (xcd - r) * q) + off; }
        const int nig = WGM * nN, gid = wgid / nig, fm = gid * WGM, gsz = (nM - fm) < WGM ? (nM - fm) : WGM;
        u.pm = fm + ((wgid % nig) % gsz); u.pn = (wgid % nig) / gsz; return true;
    }
    __device__ __forceinline__ void a_ready(const Unit&) const {}
    __device__ __forceinline__ void done(const Unit&) const {}
};

__device__ __forceinline__ unsigned cvt_pk_bf16(float lo, float hi) { unsigned r; asm volatile("v_cvt_pk_bf16_f32 %0, %1, %2" : "=v"(r) : "v"(lo), "v"(hi)); return r; }
typedef float f32x2 __attribute__((ext_vector_type(2)));
constexpr float RMS_EPS = 1e-6f, LOG2E = 1.4426950408889634f;
__device__ __forceinline__ float sigm(float g) { return __builtin_amdgcn_rcpf(1.0f + __builtin_amdgcn_exp2f(-LOG2E * g)); }
#define PG8_GAS __attribute__((address_space(1)))
typedef PG8_GAS u32x4 g_u32x4; typedef PG8_GAS const u32x4 gc_u32x4; typedef PG8_GAS const f32x4 gc_f32x4; typedef PG8_GAS float g_f32;
__device__ __forceinline__ void row_rstd8(const float* ssp, int row0, int fq, float (&rs)[2][4]) {
    f32x4 p[2][4];
#pragma unroll
    for (int ai = 0; ai < 2; ++ai)
#pragma unroll
        for (int m = 0; m < 4; ++m) p[ai][m] = *(gc_f32x4*)(ssp + (size_t)(row0 + ai * HALF + m * 16) * 16 + 4 * fq);
    asm volatile("" : "+v"(p[0][0]), "+v"(p[0][1]), "+v"(p[0][2]), "+v"(p[0][3]), "+v"(p[1][0]), "+v"(p[1][1]), "+v"(p[1][2]), "+v"(p[1][3]));
#pragma unroll
    for (int ai = 0; ai < 2; ++ai)
#pragma unroll
        for (int m = 0; m < 4; ++m) { float s = (p[ai][m][0] + p[ai][m][1]) + (p[ai][m][2] + p[ai][m][3]); s += __shfl_xor(s, 16); s += __shfl_xor(s, 32); rs[ai][m] = rsqrtf(s * (1.0f / 1024.0f) + RMS_EPS); }
}
struct EpiSwiGLU {
    static constexpr bool PERM = true, AFTER_DRAIN = false;
    bf16_t* O; int ldc; const float* ss;
    __device__ __forceinline__ void operator()(const f32x4 (&acc)[2][2][4][2], const Unit& u, int wr, int wc, int fr, int fq) const {
        const int row0 = u.pm * BM + wr * 64 + fr, col0 = u.pn * HALF + wc * 32 + 8 * fq;
        float rsv[2][4]; row_rstd8(ss, row0, fq, rsv);
#pragma unroll
        for (int ai = 0; ai < 2; ++ai)
#pragma unroll
            for (int m = 0; m < 4; ++m) { const int row = row0 + ai * HALF + m * 16; const float rs = rsv[ai][m];
                const float c1 = -LOG2E * rs, rs2 = rs * rs;
                float o[8];
#pragma unroll
                for (int n = 0; n < 2; ++n)
#pragma unroll
                    for (int e = 0; e < 4; ++e) { const float g = acc[ai][0][m][n][e], up = acc[ai][1][m][n][e];
                        const float r = __builtin_amdgcn_rcpf(1.0f + __builtin_amdgcn_exp2f(g * c1)); o[4 * n + e] = (g * up) * (r * rs2); }
                u32x4 w; w.x = cvt_pk_bf16(o[0], o[1]); w.y = cvt_pk_bf16(o[2], o[3]); w.z = cvt_pk_bf16(o[4], o[5]); w.w = cvt_pk_bf16(o[6], o[7]);
                *(g_u32x4*)(O + (size_t)row * ldc + col0) = w; }
    }
};
struct EpiInProj {
    static constexpr bool PERM = true, AFTER_DRAIN = false;
    bf16_t* QKV; bf16_t* Z; const float* ss; float qscale;
    __device__ __forceinline__ void operator()(const f32x4 (&acc)[2][2][4][2], const Unit& u, int wr, int wc, int fr, int fq) const {
        const int row0 = u.pm * BM + wr * 64 + fr;
        float rsv[2][4]; row_rstd8(ss, row0, fq, rsv);
        if (u.pn < 3) {
            const float sc = u.pn < 2 ? qscale : 1.0f; const int col0 = u.pn * BM + wc * 32 + 8 * fq;
#pragma unroll
            for (int ai = 0; ai < 2; ++ai)
#pragma unroll
                for (int m = 0; m < 4; ++m) { const int row = row0 + ai * HALF + m * 16; const float rs = rsv[ai][m] * sc;
#pragma unroll
                    for (int bj = 0; bj < 2; ++bj) { const f32x4 v0 = acc[ai][bj][m][0] * rs, v1 = acc[ai][bj][m][1] * rs;
                        u32x4 w; w.x = cvt_pk_bf16(v0[0], v0[1]); w.y = cvt_pk_bf16(v0[2], v0[3]); w.z = cvt_pk_bf16(v1[0], v1[1]); w.w = cvt_pk_bf16(v1[2], v1[3]);
                        *(g_u32x4*)(QKV + (size_t)row * 768 + col0 + bj * HALF) = w; } }
        } else {
            const int col0 = (u.pn - 3) * HALF + wc * 32 + 8 * fq;
#pragma unroll
            for (int ai = 0; ai < 2; ++ai)
#pragma unroll
                for (int m = 0; m < 4; ++m) { const int row = row0 + ai * HALF + m * 16; const float rs = rsv[ai][m];
                    float o[8];
#pragma unroll
                    for (int n = 0; n < 2; ++n)
#pragma unroll
                        for (int e = 0; e < 4; ++e) { const float a = acc[ai][0][m][n][e] * rs, g = acc[ai][1][m][n][e] * rs; o[4 * n + e] = a * sigm(g); }
                    u32x4 w; w.x = cvt_pk_bf16(o[0], o[1]); w.y = cvt_pk_bf16(o[2], o[3]); w.z = cvt_pk_bf16(o[4], o[5]); w.w = cvt_pk_bf16(o[6], o[7]);
                    *(g_u32x4*)(Z + (size_t)row * 512 + col0) = w; }
        }
    }
};
struct EpiResid {
    static constexpr bool PERM = true, AFTER_DRAIN = false;
    bf16_t* xb; float* ssacc; float scale;
    __device__ __forceinline__ void operator()(const f32x4 (&acc)[2][2][4][2], const Unit& u, int wr, int wc, int fr, int fq) const {
        const int row0 = u.pm * BM + wr * 64 + fr, col0 = u.pn * BM + wc * 32 + 8 * fq;
        bf16_t* p0 = xb + (size_t)row0 * 1024 + col0;
#pragma unroll
        for (int ai = 0; ai < 2; ++ai) {
            u32x4 xv[4][2];
#pragma unroll
            for (int m = 0; m < 4; ++m)
#pragma unroll
                for (int bj = 0; bj < 2; ++bj) xv[m][bj] = *(gc_u32x4*)(p0 + (size_t)(ai * HALF + m * 16) * 1024 + bj * HALF);
            asm volatile("" : "+v"(xv[0][0]), "+v"(xv[0][1]), "+v"(xv[1][0]), "+v"(xv[1][1]), "+v"(xv[2][0]), "+v"(xv[2][1]), "+v"(xv[3][0]), "+v"(xv[3][1]));
#pragma unroll
            for (int m = 0; m < 4; ++m) { const int row = row0 + ai * HALF + m * 16; bf16_t* p = p0 + (size_t)(ai * HALF + m * 16) * 1024; float sq = 0.f;
#pragma unroll
                for (int bj = 0; bj < 2; ++bj) { const u32x4 xw = xv[m][bj];
                    const f32x4 x0 = (f32x4){__builtin_bit_cast(float, xw.x << 16), __builtin_bit_cast(float, xw.x & 0xffff0000u), __builtin_bit_cast(float, xw.y << 16), __builtin_bit_cast(float, xw.y & 0xffff0000u)};
                    const f32x4 x1 = (f32x4){__builtin_bit_cast(float, xw.z << 16), __builtin_bit_cast(float, xw.z & 0xffff0000u), __builtin_bit_cast(float, xw.w << 16), __builtin_bit_cast(float, xw.w & 0xffff0000u)};
                    const f32x4 o0 = x0 + acc[ai][bj][m][0] * scale, o1 = x1 + acc[ai][bj][m][1] * scale;
                    u32x4 w; w.x = cvt_pk_bf16(o0[0], o0[1]); w.y = cvt_pk_bf16(o0[2], o0[3]); w.z = cvt_pk_bf16(o1[0], o1[1]); w.w = cvt_pk_bf16(o1[2], o1[3]);
                    *(g_u32x4*)(p + bj * HALF) = w;
                    sq += (o0[0] * o0[0] + o0[1] * o0[1]) + (o0[2] * o0[2] + o0[3] * o0[3]) + (o1[0] * o1[0] + o1[1] * o1[1]) + (o1[2] * o1[2] + o1[3] * o1[3]); }
                sq += __shfl_xor(sq, 16); sq += __shfl_xor(sq, 32);
                if (fq == 0) *(g_f32*)(ssacc + (size_t)row * 16 + u.pn * 4 + wc) = sq; }
        }
    }
};

template <class Epi, class Sched, bool ALIGN_EPI = false, bool SP2 = false>
__device__ __forceinline__ void gemm_phase(PG8_LAS unsigned char* lds, const Gemm g, const Sched& S, const Epi& E) {
    int tid_ = threadIdx.x; asm volatile("" : "+v"(tid_));
    const int tid = tid_, wid = __builtin_amdgcn_readfirstlane(tid >> 6), lane = tid & 63, wr = wid >> 2, wc = wid & 3, fr = lane & 15, fq = lane >> 4;
    const int K = g.K, nt = K / BK;
    unsigned voffA[2], voffB[2];
#pragma unroll
    for (int i = 0; i < 2; ++i) { int R, C; stage_rc(tid * 16 + i * 8192, R, C); const int Rb = Epi::PERM ? ((R & ~31) + perm32(R & 31)) : R;
        voffA[i] = (unsigned)(R * K + C) * 2u; voffB[i] = (unsigned)(Rb * K + C) * 2u; }
    const size_t kstep = (size_t)(BK * 2);
    const size_t hstep = (size_t)HALF * K * 2;
    const size_t tstep = 2 * hstep;
    const unsigned ldsw = (unsigned)wid * 1024u;
    const int aoff = lds_byte(wr * 64 + fr, fq * 8), boff = lds_byte(wc * 32 + fr, fq * 8);
#define PG8_SA(b, h) (((b) * 2 + (h)) * HTB)
#define PG8_SB(b, h) ((4 + (b) * 2 + (h)) * HTB)
#define PG8_STAGE(bufoff, gbase, voff) do { _Pragma("unroll") for (int _i = 0; _i < 2; ++_i) \
        __builtin_amdgcn_global_load_lds((const unsigned*)((const char*)(gbase) + (voff)[_i]), (PG8_LAS unsigned*)(lds + (bufoff) + ldsw + _i * 8192), 16, 0, 0); } while (0)
#define PG8_LDA(dst, b, h) do { _Pragma("unroll") for (int m = 0; m < 4; ++m) _Pragma("unroll") for (int k = 0; k < 2; ++k) dst[m][k] = *(const PG8_LAS bf16x8*)(lds + PG8_SA(b, h) + aoff + m * 2048 + k * 1024); } while (0)
#define PG8_LDB(dst, b, h) do { _Pragma("unroll") for (int n = 0; n < 2; ++n) _Pragma("unroll") for (int k = 0; k < 2; ++k) dst[n][k] = *(const PG8_LAS bf16x8*)(lds + PG8_SB(b, h) + boff + n * 2048 + k * 1024); } while (0)
#define PG8_MMA(ai, bj, At, Bt) do { __builtin_amdgcn_s_setprio(1); _Pragma("unroll") for (int m = 0; m < 4; ++m) _Pragma("unroll") for (int n = 0; n < 2; ++n) _Pragma("unroll") for (int k = 0; k < 2; ++k) \
        acc[ai][bj][m][n] = __builtin_amdgcn_mfma_f32_16x16x32_bf16(Bt[n][k], At[m][k], acc[ai][bj][m][n], 0, 0, 0); __builtin_amdgcn_s_setprio(0); } while (0)
#define PG8_WAIT_V(n) asm volatile("s_waitcnt vmcnt(" #n ")" ::: "memory")
#define PG8_WAIT_L(n) asm volatile("s_waitcnt lgkmcnt(" #n ")" ::: "memory")
#define PG8_BAR __builtin_amdgcn_s_barrier()
#define PG8_SCHED __builtin_amdgcn_sched_barrier(0)
    Unit cur, nxt; int ui = 0;
    if (!S.next(0, cur)) return;
    f32x4 acc[2][2][4][2];
#pragma unroll
    for (int a = 0; a < 2; ++a)
#pragma unroll
        for (int b = 0; b < 2; ++b)
#pragma unroll
            for (int m = 0; m < 4; ++m)
#pragma unroll
                for (int n = 0; n < 2; ++n) acc[a][b][m][n] = (f32x4){0.f, 0.f, 0.f, 0.f};
    bf16x8 At[4][2], B0[2][2], B1[2][2];
    const char* cA = (const char*)g.A + (size_t)cur.pm * tstep; const char* cB = (const char*)g.Bt + (size_t)cur.pn * tstep;
    S.a_ready(cur);
    if constexpr (SP2) {
        PG8_STAGE(PG8_SB(0, 0), cB, voffB); PG8_STAGE(PG8_SB(0, 1), cB + hstep, voffB); PG8_STAGE(PG8_SA(0, 0), cA, voffA); PG8_STAGE(PG8_SA(0, 1), cA + hstep, voffA);
        if (wr == 1) PG8_BAR;
        PG8_WAIT_V(2); PG8_BAR;
        PG8_STAGE(PG8_SB(1, 0), cB + kstep, voffB); PG8_STAGE(PG8_SA(1, 0), cA + kstep, voffA); PG8_STAGE(PG8_SB(1, 1), cB + hstep + kstep, voffB);
        PG8_WAIT_V(6); PG8_BAR;
    } else {
        PG8_STAGE(PG8_SB(0, 0), cB, voffB); PG8_STAGE(PG8_SA(0, 0), cA, voffA); PG8_STAGE(PG8_SB(0, 1), cB + hstep, voffB); PG8_STAGE(PG8_SA(0, 1), cA + hstep, voffA);
        if (wr == 1) PG8_BAR;
        PG8_WAIT_V(4); PG8_BAR;
        PG8_STAGE(PG8_SB(1, 0), cB + kstep, voffB); PG8_STAGE(PG8_SA(1, 0), cA + kstep, voffA); PG8_STAGE(PG8_SB(1, 1), cB + hstep + kstep, voffB);
        PG8_WAIT_V(6); PG8_BAR;
    }
    for (;;) {
        const bool has_next = S.next(ui + 1, nxt);
        const char* nA = has_next ? (const char*)g.A + (size_t)nxt.pm * tstep : cA; const char* nB = has_next ? (const char*)g.Bt + (size_t)nxt.pn * tstep : cB;
        for (int t = 0; t < nt; t += 2) {
            const bool last = (t == nt - 2);
            const char* a1 = cA + (size_t)(t + 1) * kstep;
            const char* a2 = last ? nA : cA + (size_t)(t + 2) * kstep; const char* b2 = last ? nB : cB + (size_t)(t + 2) * kstep;
            const char* a3 = a2 + kstep; const char* b3 = b2 + kstep;
            if (last && has_next) S.a_ready(nxt);
            if constexpr (SP2) {
            PG8_LDB(B0, 0, 0); PG8_LDB(B1, 0, 1); PG8_SCHED; PG8_LDA(At, 0, 0); PG8_STAGE(PG8_SA(1, 1), a1 + hstep, voffA);
            PG8_WAIT_V(8); PG8_WAIT_L(0); PG8_BAR; PG8_MMA(0, 0, At, B0); PG8_MMA(0, 1, At, B1); PG8_BAR; PG8_SCHED;
            PG8_LDA(At, 0, 1); PG8_STAGE(PG8_SB(0, 0), b2, voffB); PG8_STAGE(PG8_SB(0, 1), b2 + hstep, voffB); PG8_STAGE(PG8_SA(0, 0), a2, voffA);
            PG8_WAIT_V(8); PG8_WAIT_L(0); PG8_BAR; PG8_MMA(1, 0, At, B0); PG8_MMA(1, 1, At, B1); PG8_BAR; PG8_SCHED;
            PG8_LDB(B0, 1, 0); PG8_LDB(B1, 1, 1); PG8_SCHED; PG8_LDA(At, 1, 0); PG8_STAGE(PG8_SA(0, 1), a2 + hstep, voffA);
            PG8_WAIT_V(8); PG8_WAIT_L(0); PG8_BAR; PG8_MMA(0, 0, At, B0); PG8_MMA(0, 1, At, B1); PG8_BAR; PG8_SCHED;
            PG8_LDA(At, 1, 1); PG8_STAGE(PG8_SB(1, 0), b3, voffB); PG8_STAGE(PG8_SB(1, 1), b3 + hstep, voffB); PG8_STAGE(PG8_SA(1, 0), a3, voffA);
            PG8_WAIT_V(8); PG8_WAIT_L(0); PG8_BAR; PG8_MMA(1, 0, At, B0); PG8_MMA(1, 1, At, B1); PG8_BAR; PG8_SCHED;
            } else {
            PG8_LDB(B0, 0, 0); PG8_SCHED; PG8_LDA(At, 0, 0); PG8_STAGE(PG8_SA(1, 1), a1 + hstep, voffA);
            PG8_WAIT_L(8); PG8_BAR; PG8_WAIT_L(0); PG8_MMA(0, 0, At, B0); PG8_BAR; PG8_SCHED;
            PG8_LDB(B1, 0, 1); PG8_STAGE(PG8_SB(0, 0), b2, voffB);
            PG8_BAR; PG8_WAIT_L(0); PG8_MMA(0, 1, At, B1); PG8_BAR;
            PG8_LDA(At, 0, 1); PG8_STAGE(PG8_SA(0, 0), a2, voffA);
            PG8_BAR; PG8_WAIT_L(0); PG8_MMA(1, 0, At, B0); PG8_BAR; PG8_SCHED;
            PG8_STAGE(PG8_SB(0, 1), b2 + hstep, voffB);
            PG8_WAIT_V(6); PG8_BAR; PG8_MMA(1, 1, At, B1); PG8_BAR;
            PG8_LDB(B0, 1, 0); PG8_SCHED; PG8_LDA(At, 1, 0); PG8_STAGE(PG8_SA(0, 1), a2 + hstep, voffA);
            PG8_WAIT_L(8); PG8_BAR; PG8_WAIT_L(0); PG8_MMA(0, 0, At, B0); PG8_BAR; PG8_SCHED;
            PG8_LDB(B1, 1, 1); PG8_STAGE(PG8_SB(1, 0), b3, voffB);
            PG8_BAR; PG8_WAIT_L(0); PG8_MMA(0, 1, At, B1); PG8_BAR;
            PG8_LDA(At, 1, 1); PG8_STAGE(PG8_SA(1, 0), a3, voffA);
            PG8_BAR; PG8_WAIT_L(0); PG8_MMA(1, 0, At, B0); PG8_BAR; PG8_SCHED;
            PG8_STAGE(PG8_SB(1, 1), b3 + hstep, voffB);
            PG8_WAIT_V(6); PG8_BAR; PG8_MMA(1, 1, At, B1); PG8_BAR;
            }
        }
        if constexpr (ALIGN_EPI) { if (wr == 0) PG8_BAR; }
        if constexpr (!Epi::AFTER_DRAIN) { E(acc, cur, wr, wc, fr, fq); S.done(cur); }
        if (!has_next) break;
#pragma unroll
        for (int a = 0; a < 2; ++a)
#pragma unroll
            for (int b = 0; b < 2; ++b)
#pragma unroll
                for (int m = 0; m < 4; ++m)
#pragma unroll
                    for (int n = 0; n < 2; ++n) acc[a][b][m][n] = (f32x4){0.f, 0.f, 0.f, 0.f};
        cur = nxt; cA = nA; cB = nB; ++ui;
        if constexpr (ALIGN_EPI) { if (wr == 1) PG8_BAR; }
    }
    PG8_WAIT_V(0);
    if constexpr (!ALIGN_EPI) { if (wr == 0) PG8_BAR; }
    PG8_BAR;
    if constexpr (Epi::AFTER_DRAIN) { E.fused(acc, cur, wr, wc, fr, fq, lds, wid, lane); S.done(cur); }
#undef PG8_SA
#undef PG8_SB
#undef PG8_STAGE
#undef PG8_LDA
#undef PG8_LDB
#undef PG8_MMA
#undef PG8_WAIT_V
#undef PG8_WAIT_L
#undef PG8_BAR
#undef PG8_SCHED
}
}

constexpr int NWAVES = 8, NTHR = 512;
constexpr int BATCH = 8, SEQ = 4096, DM = 1024, DEPTH = 4, DFF = 2816, NFFI = 2 * DFF, INW = 1792, NHEADS = 8, CONVW = 31, CCH = 512;
constexpr int M = BATCH * SEQ;
constexpr float EPS = 1e-6f, L2E = 1.4426950408889634f;
constexpr size_t MiB = 1u << 20;
constexpr size_t WS_SS = 0;
constexpr size_t WS_CTL = 2 * MiB;
constexpr size_t WS_W = 4 * MiB;
constexpr size_t W_FFI = (size_t)NFFI * DM * 2, W_FFO = (size_t)DM * DFF * 2, W_IN = (size_t)INW * DM * 2, W_OUT = (size_t)DM * DM * 2;
constexpr size_t WL_FI1 = 0, WL_FO1 = WL_FI1 + W_FFI, WL_IN = WL_FO1 + W_FFO, WL_OUT = WL_IN + W_IN, WL_FI2 = WL_OUT + W_OUT, WL_FO2 = WL_FI2 + W_FFI, WL_SIZE = WL_FO2 + W_FFO;
constexpr size_t WS_XB = 160 * MiB;
constexpr size_t WS_ACT = 224 * MiB;
constexpr size_t WS_QKV = WS_ACT, WS_Z = WS_QKV + (size_t)M * 768 * 2, WS_MIX = WS_Z + (size_t)M * 512 * 2;
constexpr size_t WS_END = WS_ACT + (size_t)M * DFF * 2;
static_assert(WS_W + DEPTH * WL_SIZE <= WS_XB && WS_XB + (size_t)M * DM * 2 <= WS_ACT && WS_MIX + (size_t)M * DM * 2 <= WS_END, "d_ws map");
constexpr int RING_BYTES = 131072, LDS_BYTES = 147456;
constexpr int REP_PRO = 1, REP_MIX = 1, XSYNC = 0, REP_FFI = 1, REP_INP = 1, REP_FFI_STREAM = 1, REP_ATT = 1;

#define GAS __attribute__((address_space(1)))
#define LAS __attribute__((address_space(3)))
typedef unsigned short bf16;
typedef unsigned v4u __attribute__((ext_vector_type(4)));
typedef float f32x4 __attribute__((ext_vector_type(4)));
typedef float f32x2 __attribute__((ext_vector_type(2)));
typedef float f32x16 __attribute__((ext_vector_type(16)));
typedef short bf16x8 __attribute__((ext_vector_type(8)));
typedef short s16x4 __attribute__((ext_vector_type(4)));
#define LDS_WAIT() asm volatile("s_waitcnt lgkmcnt(0)" ::: "memory")
__device__ __forceinline__ unsigned f2bf(float f) { unsigned u = __builtin_bit_cast(unsigned, f); return (u + 0x7fffu + ((u >> 16) & 1u)) >> 16; }
__device__ __forceinline__ unsigned pk2(float lo, float hi) { return f2bf(lo) | (f2bf(hi) << 16); }
__device__ __forceinline__ unsigned cvtpk(float lo, float hi) { typedef __bf16 bf2 __attribute__((ext_vector_type(2))); f32x2 v = {lo, hi}; return __builtin_bit_cast(unsigned, __builtin_convertvector(v, bf2)); }
__device__ __forceinline__ float wave_sum(float v) {
#pragma unroll
    for (int o = 1; o < 64; o <<= 1) v += __shfl_xor(v, o);
    return v;
}

template <int MAP> __device__ __forceinline__ int colmap(int np) {
    if (MAP == 1) { const int pn = np >> 8, bj = (np >> 7) & 1, jj = np & 127; return bj * DFF + pn * 128 + jj; }
    if (MAP == 2) { if (np < 768) return np; const int r = np - 768, t = r >> 8, bj = (r >> 7) & 1, jj = r & 127; return 768 + bj * CCH + t * 128 + jj; }
    return np;
}
struct Args { const float* in[16]; float* out; unsigned char* ws; };

struct TItem { const float* src; const float* gain; bf16* dst; int N, K; };
__device__ __forceinline__ TItem titem(const Args& a, int it, int lane) {
    constexpr int I_FI = (DM / 64) * (NFFI / 32), I_FO = (DFF / 64) * (DM / 32), I_IN = (DM / 64) * (INW / 32), I_OUT = (DM / 64) * (DM / 32);
    constexpr int I_LAYER = 2 * I_FI + 2 * I_FO + I_IN + I_OUT;
    const int l = it / I_LAYER; int r = it % I_LAYER;
    unsigned char* wl = a.ws + WS_W + (size_t)l * WL_SIZE;
    const float* W; const float* gain; bf16* WT; int K, N, map;
    if (r < I_FI) { W = a.in[2] + (size_t)l * DM * NFFI; gain = a.in[1] + l * DM; WT = (bf16*)(wl + WL_FI1); K = DM; N = NFFI; map = 1; }
    else if ((r -= I_FI) < I_FI) { W = a.in[13] + (size_t)l * DM * NFFI; gain = a.in[12] + l * DM; WT = (bf16*)(wl + WL_FI2); K = DM; N = NFFI; map = 1; }
    else if ((r -= I_FI) < I_FO) { W = a.in[3] + (size_t)l * DFF * DM; gain = nullptr; WT = (bf16*)(wl + WL_FO1); K = DFF; N = DM; map = 0; }
    else if ((r -= I_FO) < I_FO) { W = a.in[14] + (size_t)l * DFF * DM; gain = nullptr; WT = (bf16*)(wl + WL_FO2); K = DFF; N = DM; map = 0; }
    else if ((r -= I_FO) < I_IN) { W = a.in[5] + (size_t)l * DM * INW; gain = a.in[4] + l * DM; WT = (bf16*)(wl + WL_IN); K = DM; N = INW; map = 2; }
    else { r -= I_IN; W = a.in[11] + (size_t)l * DM * DM; gain = nullptr; WT = (bf16*)(wl + WL_OUT); K = DM; N = DM; map = 0; }
    const int nblk = N / 32, kb = r / nblk, nb = r % nblk, k0 = 64 * kb, n0 = 32 * nb;
    const int ns = map == 1 ? colmap<1>(n0) : map == 2 ? colmap<2>(n0) : n0;
    TItem t; t.src = W + (size_t)(k0 + (lane >> 5)) * N + ns + (lane & 31); t.gain = gain ? gain + k0 + lane : nullptr;
    t.dst = WT + (size_t)(n0 + (lane >> 3)) * K + k0 + 8 * (lane & 7); t.N = N; t.K = K; return t;
}
__device__ __forceinline__ void titem_load(const TItem& t, float (&v)[32], float& gv) {
#pragma unroll
    for (int i = 0; i < 32; ++i) v[i] = __builtin_nontemporal_load(t.src + (size_t)(2 * i) * t.N);
    gv = t.gain ? *t.gain : 1.0f;
}
__device__ __forceinline__ void titem_store(const TItem& t, const float (&v)[32], float gv, LAS float* scr, int lane) {
#pragma unroll
    for (int i = 0; i < 32; ++i) { const float g0 = __builtin_bit_cast(float, __builtin_amdgcn_readlane(__builtin_bit_cast(int, gv), 2 * i)), g1 = __builtin_bit_cast(float, __builtin_amdgcn_readlane(__builtin_bit_cast(int, gv), 2 * i + 1));
        scr[(2 * i + (lane >> 5)) * 33 + (lane & 31)] = v[i] * ((lane >> 5) ? g1 : g0); }
    LDS_WAIT(); asm volatile("" ::: "memory");
    const int c = lane & 7;
#pragma unroll
    for (int j = 0; j < 4; ++j) { const int n = (lane >> 3) + 8 * j; const LAS float* s = scr + (8 * c) * 33 + n;
        v4u o; o.x = pk2(s[0 * 33], s[1 * 33]); o.y = pk2(s[2 * 33], s[3 * 33]); o.z = pk2(s[4 * 33], s[5 * 33]); o.w = pk2(s[6 * 33], s[7 * 33]);
        *(GAS v4u*)(t.dst + (size_t)(8 * j) * t.K) = o; }
    LDS_WAIT(); asm volatile("" ::: "memory");
}

__device__ __forceinline__ void prologue(const Args& a, LAS unsigned char* lds, int wave, int lane, int G) {
    asm volatile("" : "+v"(lane));
    LAS float* scr = (LAS float*)(lds + wave * 16384);
    const int gw = blockIdx.x * NWAVES + wave, NGW = G * NWAVES;
    constexpr int I_TOTAL = DEPTH * (2 * (DM / 64) * (NFFI / 32) + 2 * (DFF / 64) * (DM / 32) + (DM / 64) * (INW / 32) + (DM / 64) * (DM / 32));
    if (gw < I_TOTAL) {
        TItem cur = titem(a, gw, lane); float v[32], w[32]; float gv, gw2 = 1.0f;
        titem_load(cur, v, gv);
        for (int it = gw; it < I_TOTAL; it += NGW) {
            const int nx = it + NGW; const bool more = nx < I_TOTAL; TItem nxt = cur;
            if (more) { nxt = titem(a, nx, lane); titem_load(nxt, w, gw2); }
            titem_store(cur, v, gv, scr, lane);
            if (more) {
#pragma unroll
                for (int i = 0; i < 32; ++i) v[i] = w[i];
                gv = gw2; cur = nxt; }
        }
    }
    float* ss = (float*)(a.ws + WS_SS); bf16* XB = (bf16*)(a.ws + WS_XB);
    for (int m = gw; m < M; m += 2 * NGW) {
        const int m2 = (m + NGW < M) ? m + NGW : m;
        const GAS f32x4* xr = (const GAS f32x4*)(a.in[0] + (size_t)m * DM) + lane; const GAS f32x4* xr2 = (const GAS f32x4*)(a.in[0] + (size_t)m2 * DM) + lane;
        f32x4 v[4], w[4]; float s = 0.f, s2 = 0.f;
#pragma unroll
        for (int j = 0; j < 4; ++j) { v[j] = __builtin_nontemporal_load(xr + 64 * j); w[j] = __builtin_nontemporal_load(xr2 + 64 * j); }
#pragma unroll
        for (int j = 0; j < 4; ++j) { s += (v[j].x * v[j].x + v[j].y * v[j].y) + (v[j].z * v[j].z + v[j].w * v[j].w); s2 += (w[j].x * w[j].x + w[j].y * w[j].y) + (w[j].z * w[j].z + w[j].w * w[j].w); }
        s = wave_sum(s); s2 = wave_sum(s2);
        GAS unsigned long long* o8 = (GAS unsigned long long*)(XB + (size_t)m * DM) + lane; GAS unsigned long long* p8 = (GAS unsigned long long*)(XB + (size_t)m2 * DM) + lane;
#pragma unroll
        for (int j = 0; j < 4; ++j) { o8[64 * j] = (unsigned long long)pk2(v[j].x, v[j].y) | ((unsigned long long)pk2(v[j].z, v[j].w) << 32);
            p8[64 * j] = (unsigned long long)pk2(w[j].x, w[j].y) | ((unsigned long long)pk2(w[j].z, w[j].w) << 32); }
        if (lane < 16) { ss[(size_t)m * 16 + lane] = lane == 0 ? s : 0.f; ss[(size_t)m2 * 16 + lane] = lane == 0 ? s2 : 0.f; }
    }
}

constexpr int AT_ROWB = 144, AT_VOFF = 256 * AT_ROWB;
__device__ __forceinline__ s16x4 vtr(const LAS unsigned char* p) { return __builtin_bit_cast(s16x4, __builtin_amdgcn_ds_read_tr16_b64_v4i16((LAS s16x4*)p)); }
__device__ __forceinline__ void attn_unit(LAS unsigned char* lds, int unit, const bf16* QKV, bf16* MIX, const float* sinks_l) {
    int tid = threadIdx.x; asm volatile("" : "+v"(tid));
    const int lane_ = tid & 63, wid = __builtin_amdgcn_readfirstlane(tid >> 6);
    const int kvh = unit & 1, n = (unit >> 1) & 31, b = unit >> 6;
    const size_t tok0 = (size_t)b * SEQ + (size_t)n * 128;
    const int hg = kvh * 4 + (wid >> 1);
    bf16x8 qa[2][4];
#pragma unroll
    for (int ii = 0; ii < 2; ++ii) { const bf16* qp = QKV + (tok0 + 32 * (2 * (wid & 1) + ii) + (lane_ & 31)) * 768 + hg * 64 + (lane_ >> 5) * 8;
#pragma unroll
        for (int d0 = 0; d0 < 4; ++d0) qa[ii][d0] = *(const bf16x8*)(qp + d0 * 16); }
#pragma unroll
    for (int i = 0; i < 4; ++i) { const int idx = tid + NTHR * i, row = idx >> 3, ch = idx & 7;
        v4u kv = (v4u){0u, 0u, 0u, 0u}, vv = kv;
        if (n > 0 || row >= 128) { const bf16* src = QKV + (tok0 + row - 128) * 768 + 512 + kvh * 64 + ch * 8; kv = *(const v4u*)src; vv = *(const v4u*)(src + 128); }
        *(LAS v4u*)(lds + row * AT_ROWB + ch * 16) = kv; *(LAS v4u*)(lds + AT_VOFF + row * AT_ROWB + ch * 16) = vv; }
    __syncthreads();
    const float slope2 = __builtin_amdgcn_exp2f(-(float)(hg + 1)) * L2E, sink2 = sinks_l[hg] * L2E;
#pragma unroll
    for (int ii = 0; ii < 2; ++ii) {
        int lane = lane_; asm volatile("" : "+v"(lane));
        const int r32 = lane & 31, hi = lane >> 5;
        const int i = 2 * (wid & 1) + ii;
        bf16x8 qr[4];
#pragma unroll
        for (int d0 = 0; d0 < 4; ++d0) qr[d0] = ii ? qa[1][d0] : qa[0][d0];
        f32x16 S[5];
#pragma unroll
        for (int t = 0; t < 5; ++t) { const LAS unsigned char* kp = lds + (32 * (i + t) + r32) * AT_ROWB + hi * 16;
#pragma unroll
            for (int e = 0; e < 16; ++e) S[t][e] = 0.f;
#pragma unroll
            for (int d0 = 0; d0 < 4; ++d0) { const bf16x8 kf = *(const LAS bf16x8*)(kp + d0 * 32); S[t] = __builtin_amdgcn_mfma_f32_32x32x16_bf16(kf, qr[d0], S[t], 0, 0, 0); } }
        const int rb = r32 - 4 * hi + 128, tl = 32 * i + r32; const unsigned lim = (unsigned)(n > 0 ? 127 : (tl < 127 ? tl : 127));
        float mx = sink2;
        const float nrb = -slope2 * (float)rb;
        if (n > 0) {
#pragma unroll
            for (int t = 0; t < 5; ++t)
#pragma unroll
                for (int r = 0; r < 16; ++r) { const int cst = 32 * t + (r & 3) + 8 * (r >> 2);
                    float s = (S[t][r] + nrb) + slope2 * (float)cst;
                    if (t == 0) s = (rb - cst <= 127) ? s : -1e30f;
                    if (t == 4) s = (rb - cst >= 0) ? s : -1e30f;
                    S[t][r] = s; mx = fmaxf(mx, s); }
        } else {
#pragma unroll
            for (int t = 0; t < 5; ++t)
#pragma unroll
                for (int r = 0; r < 16; ++r) { const int cst = 32 * t + (r & 3) + 8 * (r >> 2); const int dist = rb - cst;
                    const float s = ((unsigned)dist <= lim) ? (S[t][r] + nrb) + slope2 * (float)cst : -1e30f; S[t][r] = s; mx = fmaxf(mx, s); }
        }
        mx = fmaxf(mx, __shfl_xor(mx, 32));
        float l = 0.f;
#pragma unroll
        for (int t = 0; t < 5; ++t)
#pragma unroll
            for (int r = 0; r < 16; ++r) { const float p = __builtin_amdgcn_exp2f(S[t][r] - mx); S[t][r] = p; l += p; }
        l += __shfl_xor(l, 32); l += __builtin_amdgcn_exp2f(sink2 - mx);
        const float inv = 1.0f / l;
        f32x16 o0, o1;
#pragma unroll
        for (int e = 0; e < 16; ++e) { o0[e] = 0.f; o1[e] = 0.f; }
#pragma unroll
        for (int t = 0; t < 5; ++t)
#pragma unroll
            for (int s = 0; s < 2; ++s) {
                v4u pw; pw.x = cvtpk(S[t][8 * s + 0] * inv, S[t][8 * s + 1] * inv); pw.y = cvtpk(S[t][8 * s + 2] * inv, S[t][8 * s + 3] * inv);
                pw.z = cvtpk(S[t][8 * s + 4] * inv, S[t][8 * s + 5] * inv); pw.w = cvtpk(S[t][8 * s + 6] * inv, S[t][8 * s + 7] * inv);
                const bf16x8 pa = __builtin_bit_cast(bf16x8, pw);
                const LAS unsigned char* vp = lds + AT_VOFF + (32 * (i + t) + 16 * s + 4 * hi + ((lane & 15) >> 2)) * AT_ROWB + (16 * ((lane >> 4) & 1) + 4 * (lane & 3)) * 2;
                const s16x4 l0 = vtr(vp), h0 = vtr(vp + 8 * AT_ROWB), l1 = vtr(vp + 64), h1 = vtr(vp + 8 * AT_ROWB + 64);
                const bf16x8 v0 = (bf16x8){l0[0], l0[1], l0[2], l0[3], h0[0], h0[1], h0[2], h0[3]}, v1 = (bf16x8){l1[0], l1[1], l1[2], l1[3], h1[0], h1[1], h1[2], h1[3]};
                o0 = __builtin_amdgcn_mfma_f32_32x32x16_bf16(pa, v0, o0, 0, 0, 0); o1 = __builtin_amdgcn_mfma_f32_32x32x16_bf16(pa, v1, o1, 0, 0, 0); }
        bf16* op = MIX + (tok0 + 32 * i) * 1024 + hg * 64 + r32;
#pragma unroll
        for (int r = 0; r < 16; ++r) { const int q = (r & 3) + 8 * (r >> 2) + 4 * hi; const unsigned w2 = cvtpk(o0[r], o1[r]); op[(size_t)q * 1024] = (bf16)(w2 & 0xffffu); op[(size_t)q * 1024 + 32] = (bf16)(w2 >> 16); }
    }
    __syncthreads();
}

constexpr int CV_YOFF = 62 * 1024;
__device__ __forceinline__ void conv_unit(LAS unsigned char* lds, int cu, const bf16* Z, bf16* MIX, const float* wdw, const float* bdw, const float* lng, const float* lnb) {
    int tid = threadIdx.x; asm volatile("" : "+v"(tid));
    const int lane = tid & 63, wid = __builtin_amdgcn_readfirstlane(tid >> 6);
    const int b = cu >> 7, t0 = (cu & 127) * 32; const size_t tokb = (size_t)b * SEQ;
#pragma unroll
    for (int i = 0; i < 8; ++i) { const int idx = tid + NTHR * i;
        if (idx < 62 * 64) { const int row = idx >> 6, ch = idx & 63, t = t0 - 30 + row; v4u v = (v4u){0u, 0u, 0u, 0u};
            if (t >= 0) v = *(const v4u*)(Z + (tokb + t) * CCH + ch * 8);
            *(LAS v4u*)(lds + row * 1024 + ch * 16) = v; } }
    const int c2 = tid & 255, half = __builtin_amdgcn_readfirstlane(tid >> 8);
    f32x2 w2[CONVW];
#pragma unroll
    for (int k = 0; k < CONVW; ++k) w2[k] = *(const f32x2*)(wdw + k * CCH + 2 * c2);
    const f32x2 bb = *(const f32x2*)(bdw + 2 * c2);
    __syncthreads();
    {
        f32x2 ac[16];
#pragma unroll
        for (int o = 0; o < 16; ++o) ac[o] = bb;
        const LAS unsigned char* zp = lds + (16 * half) * 1024 + c2 * 4;
#pragma unroll
        for (int jj = 0; jj < 46; ++jj) { const unsigned zz = *(const LAS unsigned*)(zp + jj * 1024);
            const f32x2 z2 = (f32x2){__builtin_bit_cast(float, zz << 16), __builtin_bit_cast(float, zz & 0xffff0000u)};
#pragma unroll
            for (int o = 0; o < 16; ++o) { const int k = jj - o; if (k >= 0 && k < CONVW) ac[o] += w2[k] * z2; } }
        LAS float* yp = (LAS float*)(lds + CV_YOFF) + (16 * half) * CCH + 2 * c2;
#pragma unroll
        for (int o = 0; o < 16; ++o) *(LAS f32x2*)(yp + o * CCH) = ac[o];
    }
    __syncthreads();
    {
        const f32x4 g0 = *(const f32x4*)(lng + lane * 8), g1 = *(const f32x4*)(lng + lane * 8 + 4), b0 = *(const f32x4*)(lnb + lane * 8), b1 = *(const f32x4*)(lnb + lane * 8 + 4);
#pragma unroll
        for (int q = 0; q < 4; ++q) { const int tl = 4 * wid + q; const LAS float* yr = (const LAS float*)(lds + CV_YOFF) + tl * CCH + lane * 8;
            f32x4 v0 = *(const LAS f32x4*)yr, v1 = *(const LAS f32x4*)(yr + 4);
            const float mean = wave_sum((v0.x + v0.y) + (v0.z + v0.w) + (v1.x + v1.y) + (v1.z + v1.w)) * (1.0f / CCH);
            v0 = v0 - mean; v1 = v1 - mean;
            const float var = wave_sum((v0.x * v0.x + v0.y * v0.y) + (v0.z * v0.z + v0.w * v0.w) + (v1.x * v1.x + v1.y * v1.y) + (v1.z * v1.z + v1.w * v1.w)) * (1.0f / CCH);
            const float rstd = rsqrtf(var + EPS);
            v0 = v0 * rstd * g0 + b0; v1 = v1 * rstd * g1 + b1;
            float y[8] = {v0.x, v0.y, v0.z, v0.w, v1.x, v1.y, v1.z, v1.w};
#pragma unroll
            for (int e = 0; e < 8; ++e) y[e] = y[e] * __builtin_amdgcn_rcpf(1.0f + __builtin_amdgcn_exp2f(-L2E * y[e]));
            v4u o; o.x = pk2(y[0], y[1]); o.y = pk2(y[2], y[3]); o.z = pk2(y[4], y[5]); o.w = pk2(y[6], y[7]);
            *(v4u*)(MIX + (tokb + t0 + tl) * 1024 + 512 + lane * 8) = o; }
    }
    __syncthreads();
}

typedef GAS unsigned gu32;
#define XB_TMO      128
#define XB_XCNT(j)  (256  + 64 * (j))
#define XB_XSUB(j)  (1280 + 64 * (j))
#define XB_XGEN(j)  (2304 + 64 * (j))
#define XB_TOP      3328
#define XB_TOPGEN   3392
#define XCD_BAR_WORDS 3456
#define XB_SPIN_CAP (1u << 18)

__device__ __forceinline__ unsigned xb_ld(unsigned* p)              { return __hip_atomic_load(p, __ATOMIC_RELAXED, __HIP_MEMORY_SCOPE_AGENT); }
__device__ __forceinline__ unsigned xb_add(unsigned* p, unsigned v) { return __hip_atomic_fetch_add(p, v, __ATOMIC_RELAXED, __HIP_MEMORY_SCOPE_AGENT); }
__device__ __forceinline__ unsigned xb_xcc_id() { return (unsigned)__builtin_amdgcn_s_getreg((3 << 11) | 20) & 0xFu; }
#define XB_SPIN(cond, bar) do { unsigned _sp = 0; while (cond) { __builtin_amdgcn_s_sleep(1); \
    if ((++_sp & 255u) == 0u) { if (xb_ld(&(bar)[XB_TMO])) break; if (_sp > XB_SPIN_CAP) { atomicAdd(&(bar)[XB_TMO], 1u); break; } } } } while (0)

struct XcdBarrier {
    unsigned* bar; unsigned x;
    volatile LAS unsigned* st;
};

__device__ __forceinline__ XcdBarrier xcd_barrier_post(unsigned* bar, volatile LAS unsigned* st) {
    XcdBarrier b; b.bar = bar; b.x = xb_xcc_id(); b.st = st;
    if (threadIdx.x == 0) (void)xb_add(&bar[XB_XCNT(b.x)], 1u);
    return b;
}
__device__ __forceinline__ void xcd_barrier_complete(unsigned* bar, unsigned x, unsigned& nloc, unsigned& nx) {
    const unsigned G = gridDim.x * gridDim.y * gridDim.z;
    unsigned sum, cnt, mine, sp = 0u;
    for (;;) {
        sum = 0u; cnt = 0u; mine = 0u;
#pragma unroll
        for (unsigned j = 0; j < 16; ++j) { const unsigned c = xb_ld(&bar[XB_XCNT(j)]); sum += c; cnt += (c > 0u) ? 1u : 0u; }
        if (sum == G) { mine = xb_ld(&bar[XB_XCNT(x)]); break; }
        __builtin_amdgcn_s_sleep(1);
        if ((++sp & 255u) == 0u) { if (xb_ld(&bar[XB_TMO])) break; if (sp > XB_SPIN_CAP) { atomicAdd(&bar[XB_TMO], 1u); break; } }
    }
    nloc = mine > 0u ? mine : 1u; nx = cnt > 0u ? cnt : 1u;
}

__device__ __forceinline__ void xcd_barrier(const XcdBarrier& b) {
    asm volatile("s_waitcnt vmcnt(0)" ::: "memory");
    __syncthreads();
    if (threadIdx.x == 0) {
        unsigned* bar = b.bar;
        __builtin_amdgcn_s_waitcnt(0);
        unsigned nloc = b.st[0], nx = b.st[1];
        if (nloc == 0u) { xcd_barrier_complete(bar, b.x, nloc, nx); b.st[0] = nloc; b.st[1] = nx; }
        const unsigned old = xb_add(&bar[XB_XSUB(b.x)], 1u);
        const unsigned gen = old / nloc;
        if (old + 1u == (gen + 1u) * nloc) {
            __builtin_amdgcn_fence(__ATOMIC_RELEASE, "agent");
            asm volatile("s_waitcnt vmcnt(0)" ::: "memory");
            const unsigned og = xb_add(&bar[XB_TOP], 1u);
            const unsigned tg = og / nx;
            if (og + 1u == (tg + 1u) * nx) xb_add(&bar[XB_TOPGEN], 1u);
            else XB_SPIN(xb_ld(&bar[XB_TOPGEN]) == tg, bar);
            __builtin_amdgcn_fence(__ATOMIC_ACQUIRE, "agent");
            xb_add(&bar[XB_XGEN(b.x)], 1u);
            asm volatile("s_waitcnt vmcnt(0)" ::: "memory");
        } else {
            XB_SPIN(xb_ld(&bar[XB_XGEN(b.x)]) == gen, bar);
            __builtin_amdgcn_fence(__ATOMIC_ACQUIRE, "agent");
            asm volatile("s_waitcnt vmcnt(0)" ::: "memory");
        }
    }
    __syncthreads();
}

template <class T> __device__ __forceinline__ T* lnd(T* p) { asm volatile("" : "+s"(p)); return p; }
#define GRID_SYNC() xcd_barrier(bar)
#define CG_SYNC() do { asm volatile("s_waitcnt vmcnt(0) lgkmcnt(0)" ::: "memory"); __syncthreads(); grid.sync(); \
    __builtin_amdgcn_fence(__ATOMIC_ACQUIRE, "agent"); asm volatile("s_waitcnt vmcnt(0)" ::: "memory"); __syncthreads(); } while (0)
__global__ void __launch_bounds__(NTHR, 2) fwd_mega(Args a) {
    extern __shared__ __attribute__((aligned(16))) unsigned char lds_raw[];
    cg::grid_group grid = cg::this_grid();
    LAS unsigned char* lds = (LAS unsigned char*)lds_raw;
    const int tid = threadIdx.x, lane = tid & 63, wave = __builtin_amdgcn_readfirstlane(tid >> 6), G = gridDim.x;
    unsigned char* ws = a.ws;
    float* SS = (float*)(ws + WS_SS); bf16* XB = (bf16*)(ws + WS_XB); bf16* ACT = (bf16*)(ws + WS_ACT);
    bf16* QKV = (bf16*)(ws + WS_QKV); bf16* Z = (bf16*)(ws + WS_Z); bf16* MIX = (bf16*)(ws + WS_MIX);
    float* X = a.out;

    volatile LAS unsigned* bst = (volatile LAS unsigned*)(lds + RING_BYTES);
    if (tid < 2) bst[tid] = 0u;
    unsigned* barw = (unsigned*)(ws + WS_CTL);
    if (blockIdx.x == 0) for (int w = tid; w < XCD_BAR_WORDS; w += NTHR) barw[w] = 0u;
    for (int rep = 0; rep < REP_PRO; ++rep) { prologue(a, lds, wave, lane, G); CG_SYNC(); }
    const XcdBarrier bar = xcd_barrier_post(barw, bst);
    for (int rep = 0; rep < XSYNC; ++rep) GRID_SYNC();

    for (int l = 0; l < DEPTH; ++l) {
        unsigned char* wl = ws + WS_W + (size_t)l * WL_SIZE;
        for (int part = 0; part < 3; ++part) {
            if (part != 1) {
                const bf16* Wi = (const bf16*)(wl + (part == 0 ? WL_FI1 : WL_FI2)); const bf16* Wo = (const bf16*)(wl + (part == 0 ? WL_FO1 : WL_FO2));
                for (int rep = 0; rep < REP_FFI; ++rep) {
                    pg8::Gemm g{lnd(XB), lnd(Wi), M, NFFI, DM}; pg8::StaticOrder S; S.init(M, NFFI, G, (int)blockIdx.x, REP_FFI_STREAM);
                    pg8::EpiSwiGLU E{lnd(ACT), DFF, lnd(SS)};
                    pg8::gemm_phase<pg8::EpiSwiGLU, pg8::StaticOrder, true, true>(lds, g, S, E);
                    GRID_SYNC();
                }
                {
                    pg8::Gemm g{lnd(ACT), lnd(Wo), M, DM, DFF}; pg8::StaticOrder S; S.init(M, DM, G, (int)blockIdx.x);
                    pg8::EpiResid E{lnd(XB), lnd(SS), 0.5f};
                    pg8::gemm_phase<pg8::EpiResid, pg8::StaticOrder, true, true>(lds, g, S, E);
                }
                GRID_SYNC();
            } else {
                for (int rep = 0; rep < REP_INP; ++rep) {
                    pg8::Gemm g{lnd(XB), lnd((const bf16*)(wl + WL_IN)), M, INW, DM}; pg8::StaticOrder S; S.init(M, INW, G, (int)blockIdx.x);
                    pg8::EpiInProj E{lnd(QKV), lnd(Z), lnd(SS), 0.125f * L2E};
                    pg8::gemm_phase<pg8::EpiInProj, pg8::StaticOrder, true, true>(lds, g, S, E);
                    GRID_SYNC();
                }
                for (int rep = 0; rep < REP_MIX; ++rep)
                for (int u = blockIdx.x; u < 512 + 1024; u += G) {
                    if (u < 512) { for (int r2 = 0; r2 < REP_ATT; ++r2) attn_unit(lds, u, lnd(QKV), lnd(MIX), a.in[6] + l * NHEADS); }
                    else conv_unit(lds, u - 512, lnd(Z), lnd(MIX), a.in[7] + (size_t)l * CONVW * CCH, a.in[8] + l * CCH, a.in[9] + l * CCH, a.in[10] + l * CCH);
                }
                GRID_SYNC();
                {
                    pg8::Gemm g{lnd(MIX), lnd((const bf16*)(wl + WL_OUT)), M, DM, DM}; pg8::StaticOrder S; S.init(M, DM, G, (int)blockIdx.x);
                    pg8::EpiResid E{lnd(XB), lnd(SS), 1.0f};
                    pg8::gemm_phase<pg8::EpiResid, pg8::StaticOrder, true, true>(lds, g, S, E);
                }
                GRID_SYNC();
            }
        }
    }
    {
        const float* ssf = lnd(SS); const float* gf = a.in[15]; const bf16* xbf = lnd(XB);
        int lane = tid & 63; asm volatile("" : "+v"(lane));
        const int gw = blockIdx.x * NWAVES + wave, NGW = G * NWAVES;
        f32x4 gv[4];
#pragma unroll
        for (int q = 0; q < 2; ++q) { gv[2 * q] = *((const f32x4*)gf + 2 * (lane + 64 * q)); gv[2 * q + 1] = *((const f32x4*)gf + 2 * (lane + 64 * q) + 1); }
        for (int m = gw; m < M; m += NGW) {
            const f32x4 pp = *(const f32x4*)(ssf + (size_t)m * 16 + 4 * (lane & 3)); float sq = (pp[0] + pp[1]) + (pp[2] + pp[3]); sq += __shfl_xor(sq, 1); sq += __shfl_xor(sq, 2);
            const float rs = rsqrtf(sq * (1.0f / DM) + EPS);
#pragma unroll
            for (int q = 0; q < 2; ++q) { const v4u xv = *((const v4u*)(xbf + (size_t)m * DM) + lane + 64 * q);
                const f32x4 x0 = (f32x4){__builtin_bit_cast(float, xv.x << 16), __builtin_bit_cast(float, xv.x & 0xffff0000u), __builtin_bit_cast(float, xv.y << 16), __builtin_bit_cast(float, xv.y & 0xffff0000u)};
                const f32x4 x1 = (f32x4){__builtin_bit_cast(float, xv.z << 16), __builtin_bit_cast(float, xv.z & 0xffff0000u), __builtin_bit_cast(float, xv.w << 16), __builtin_bit_cast(float, xv.w & 0xffff0000u)};
                f32x4* o = (f32x4*)(X + (size_t)m * DM) + 2 * (lane + 64 * q);
                o[0] = x0 * rs * gv[2 * q]; o[1] = x1 * rs * gv[2 * q + 1]; } }
    }
}

extern "C" void kernel_launch(void* const* d_in, const int* in_sizes, int n_in, void* d_out, int out_size, void* d_ws, size_t ws_size, hipStream_t stream) {
    static int grid = 0;
    if (grid == 0) {
        if (n_in != 16 || in_sizes[0] != M * DM || out_size != M * DM || ws_size < WS_END) { fprintf(stderr, "kernel_launch: unexpected shapes / workspace (n_in %d, ws %zu, need %zu)\n", n_in, ws_size, (size_t)WS_END); grid = -1; return; }
        int dev = 0, cus = 0, per_cu = 0;
        (void)hipGetDevice(&dev); (void)hipDeviceGetAttribute(&cus, hipDeviceAttributeMultiprocessorCount, dev);
        if (hipFuncSetAttribute((const void*)fwd_mega, hipFuncAttributeMaxDynamicSharedMemorySize, LDS_BYTES) != hipSuccess) { fprintf(stderr, "kernel_launch: hipFuncSetAttribute failed\n"); grid = -1; return; }
        if (hipOccupancyMaxActiveBlocksPerMultiprocessor(&per_cu, (const void*)fwd_mega, NTHR, LDS_BYTES) != hipSuccess || per_cu < 1) { fprintf(stderr, "kernel_launch: occupancy query says %d\n", per_cu); per_cu = 1; }
        (void)hipGetLastError();
        grid = cus * 1;
    }
    if (grid < 0) return;
    Args a{};
    for (int i = 0; i < 16; ++i) a.in[i] = (const float*)d_in[i];
    a.out = (float*)d_out; a.ws = (unsigned char*)d_ws;
    void* args[] = {&a};
    hipError_t e = hipLaunchCooperativeKernel((const void*)fwd_mega, dim3(grid), dim3(NTHR), args, LDS_BYTES, stream);
    if (e != hipSuccess) fprintf(stderr, "cooperative launch failed: %s (grid %d)\n", hipGetErrorString(e), grid);
}
```

```cpp
#include <hip/hip_runtime.h>
#include <hip/hip_cooperative_groups.h>
#include <cstdio>
#include <cstdint>
namespace cg = cooperative_groups;
namespace pg8 {
#define PG8_LAS __attribute__((address_space(3)))
typedef unsigned short bf16_t;
typedef short bf16x8 __attribute__((ext_vector_type(8)));
typedef float f32x4 __attribute__((ext_vector_type(4)));
typedef unsigned u32x4 __attribute__((ext_vector_type(4)));
constexpr int BM = 256, BK = 64, HALF = 128, HTB = HALF * BK * 2  , STAGE_BYTES = 8 * HTB, NXCD = 8, WGM = 4;

__host__ __device__ __forceinline__ int lds_byte(int r, int c) { const int st = (r >> 4) * 2 + (c >> 5), rr = r & 15, cc = c & 31, ob = rr * 64 + cc * 2; return st * 1024 + (ob ^ (((ob >> 9) & 1) << 5)); }
__host__ __device__ __forceinline__ void stage_rc(int b, int& R, int& C) { const int st = b / 1024, sb = b % 1024, swz = sb ^ (((sb >> 9) & 1) << 5); R = (st >> 1) * 16 + swz / 64; C = (st & 1) * 32 + (swz % 64) / 2; }
__host__ __device__ __forceinline__ int perm32(int rho) { const int n = rho >> 4, i = rho & 15; return 8 * (i >> 2) + 4 * n + (i & 3); }

struct Unit { int pm, pn; };
struct Gemm { const bf16_t* A; const bf16_t* Bt; int M, N, K; };

struct StaticOrder {
    int nM, nN, nwg, G, c, rep;
    __host__ __device__ void init(int M, int N, int G_, int c_, int rep_ = 1) { nM = M / BM; nN = N / BM; nwg = nM * nN; G = G_; c = c_; rep = rep_; }
    __host__ __device__ bool next(int i, Unit& u) const {
        const int R = (nwg + G - 1) / G; if (i >= R * rep) return false; i = i % R;
        const long L = (long)i * G + c; if (L >= nwg) return false;
        int wgid = (int)L; { const int q = nwg / NXCD, r = nwg % NXCD, xcd = wgid % NXCD, off = wgid / NXCD; wgid = (xcd < r ? xcd * (q + 1) : r * (q + 1) + (xcd - r) * q) + off; }
        const int nig = WGM * nN, gid = wgid / nig, fm = gid * WGM, gsz = (nM - fm) < WGM ? (nM - fm) : WGM;
        u.pm = fm + ((wgid % nig) % gsz); u.pn = (wgid % nig) / gsz; return true;
    }
    __device__ __forceinline__ void a_ready(const Unit&) const {}
    __device__ __forceinline__ void done(const Unit&) const {}
};

__device__ __forceinline__ unsigned cvt_pk_bf16(float lo, float hi) { unsigned r; asm volatile("v_cvt_pk_bf16_f32 %0, %1, %2" : "=v"(r) : "v"(lo), "v"(hi)); return r; }
typedef float f32x2 __attribute__((ext_vector_type(2)));
constexpr float RMS_EPS = 1e-6f, LOG2E = 1.4426950408889634f;
__device__ __forceinline__ float sigm(float g) { return __builtin_amdgcn_rcpf(1.0f + __builtin_amdgcn_exp2f(-LOG2E * g)); }
#define PG8_GAS __attribute__((address_space(1)))
typedef PG8_GAS u32x4 g_u32x4; typedef PG8_GAS const u32x4 gc_u32x4; typedef PG8_GAS const f32x4 gc_f32x4; typedef PG8_GAS float g_f32;
__device__ __forceinline__ void row_rstd8(const float* ssp, int row0, int fq, float (&rs)[2][4]) {
    f32x4 p[2][4];
#pragma unroll
    for (int ai = 0; ai < 2; ++ai)
#pragma unroll
        for (int m = 0; m < 4; ++m) p[ai][m] = *(gc_f32x4*)(ssp + (size_t)(row0 + ai * HALF + m * 16) * 16 + 4 * fq);
    asm volatile("" : "+v"(p[0][0]), "+v"(p[0][1]), "+v"(p[0][2]), "+v"(p[0][3]), "+v"(p[1][0]), "+v"(p[1][1]), "+v"(p[1][2]), "+v"(p[1][3]));
#pragma unroll
    for (int ai = 0; ai < 2; ++ai)
#pragma unroll
        for (int m = 0; m < 4; ++m) { float s = (p[ai][m][0] + p[ai][m][1]) + (p[ai][m][2] + p[ai][m][3]); s += __shfl_xor(s, 16); s += __shfl_xor(s, 32); rs[ai][m] = rsqrtf(s * (1.0f / 1024.0f) + RMS_EPS); }
}
struct EpiSwiGLU {
    static constexpr bool PERM = true, AFTER_DRAIN = false;
    bf16_t* O; int ldc; const float* ss;
    __device__ __forceinline__ void operator()(const f32x4 (&acc)[2][2][4][2], const Unit& u, int wr, int wc, int fr, int fq) const {
        const int row0 = u.pm * BM + wr * 64 + fr, col0 = u.pn * HALF + wc * 32 + 8 * fq;
        float rsv[2][4]; row_rstd8(ss, row0, fq, rsv);
#pragma unroll
        for (int ai = 0; ai < 2; ++ai)
#pragma unroll
            for (int m = 0; m < 4; ++m) { const int row = row0 + ai * HALF + m * 16; const float rs = rsv[ai][m];
                const float c1 = -LOG2E * rs, rs2 = rs * rs;
                float o[8];
#pragma unroll
                for (int n = 0; n < 2; ++n)
#pragma unroll
                    for (int e = 0; e < 4; ++e) { const float g = acc[ai][0][m][n][e], up = acc[ai][1][m][n][e];
                        const float r = __builtin_amdgcn_rcpf(1.0f + __builtin_amdgcn_exp2f(g * c1)); o[4 * n + e] = (g * up) * (r * rs2); }
                u32x4 w; w.x = cvt_pk_bf16(o[0], o[1]); w.y = cvt_pk_bf16(o[2], o[3]); w.z = cvt_pk_bf16(o[4], o[5]); w.w = cvt_pk_bf16(o[6], o[7]);
                *(g_u32x4*)(O + (size_t)row * ldc + col0) = w; }
    }
};
struct EpiInProj {
    static constexpr bool PERM = true, AFTER_DRAIN = false;
    bf16_t* QKV; bf16_t* Z; const float* ss; float qscale;
    __device__ __forceinline__ void operator()(const f32x4 (&acc)[2][2][4][2], const Unit& u, int wr, int wc, int fr, int fq) const {
        const int row0 = u.pm * BM + wr * 64 + fr;
        float rsv[2][4]; row_rstd8(ss, row0, fq, rsv);
        if (u.pn < 3) {
            const float sc = u.pn < 2 ? qscale : 1.0f; const int col0 = u.pn * BM + wc * 32 + 8 * fq;
#pragma unroll
            for (int ai = 0; ai < 2; ++ai)
#pragma unroll
                for (int m = 0; m < 4; ++m) { const int row = row0 + ai * HALF + m * 16; const float rs = rsv[ai][m] * sc;
#pragma unroll
                    for (int bj = 0; bj < 2; ++bj) { const f32x4 v0 = acc[ai][bj][m][0] * rs, v1 = acc[ai][bj][m][1] * rs;
                        u32x4 w; w.x = cvt_pk_bf16(v0[0], v0[1]); w.y = cvt_pk_bf16(v0[2], v0[3]); w.z = cvt_pk_bf16(v1[0], v1[1]); w.w = cvt_pk_bf16(v1[2], v1[3]);
                        *(g_u32x4*)(QKV + (size_t)row * 768 + col0 + bj * HALF) = w; } }
        } else {
            const int col0 = (u.pn - 3) * HALF + wc * 32 + 8 * fq;
#pragma unroll
            for (int ai = 0; ai < 2; ++ai)
#pragma unroll
                for (int m = 0; m < 4; ++m) { const int row = row0 + ai * HALF + m * 16; const float rs = rsv[ai][m];
                    float o[8];
#pragma unroll
                    for (int n = 0; n < 2; ++n)
#pragma unroll
                        for (int e = 0; e < 4; ++e) { const float a = acc[ai][0][m][n][e] * rs, g = acc[ai][1][m][n][e] * rs; o[4 * n + e] = a * sigm(g); }
                    u32x4 w; w.x = cvt_pk_bf16(o[0], o[1]); w.y = cvt_pk_bf16(o[2], o[3]); w.z = cvt_pk_bf16(o[4], o[5]); w.w = cvt_pk_bf16(o[6], o[7]);
                    *(g_u32x4*)(Z + (size_t)row * 512 + col0) = w; }
        }
    }
};
struct EpiResid {
    static constexpr bool PERM = true, AFTER_DRAIN = false;
    bf16_t* xb; float* ssacc; float scale;
    __device__ __forceinline__ void operator()(const f32x4 (&acc)[2][2][4][2], const Unit& u, int wr, int wc, int fr, int fq) const {
        const int row0 = u.pm * BM + wr * 64 + fr, col0 = u.pn * BM + wc * 32 + 8 * fq;
#pragma unroll
        for (int ai = 0; ai < 2; ++ai)
#pragma unroll
            for (int m = 0; m < 4; ++m) { const int row = row0 + ai * HALF + m * 16; bf16_t* p = xb + (size_t)row * 1024 + col0; float sq = 0.f;
                const u32x4 xv0 = *(gc_u32x4*)p, xv1 = *(gc_u32x4*)(p + HALF);
#pragma unroll
                for (int bj = 0; bj < 2; ++bj) { const u32x4 xv = bj ? xv1 : xv0;
                    const f32x4 x0 = (f32x4){__builtin_bit_cast(float, xv.x << 16), __builtin_bit_cast(float, xv.x & 0xffff0000u), __builtin_bit_cast(float, xv.y << 16), __builtin_bit_cast(float, xv.y & 0xffff0000u)};
                    const f32x4 x1 = (f32x4){__builtin_bit_cast(float, xv.z << 16), __builtin_bit_cast(float, xv.z & 0xffff0000u), __builtin_bit_cast(float, xv.w << 16), __builtin_bit_cast(float, xv.w & 0xffff0000u)};
                    const f32x4 o0 = x0 + acc[ai][bj][m][0] * scale, o1 = x1 + acc[ai][bj][m][1] * scale;
                    u32x4 w; w.x = cvt_pk_bf16(o0[0], o0[1]); w.y = cvt_pk_bf16(o0[2], o0[3]); w.z = cvt_pk_bf16(o1[0], o1[1]); w.w = cvt_pk_bf16(o1[2], o1[3]);
                    *(g_u32x4*)(p + bj * HALF) = w;
                    sq += (o0[0] * o0[0] + o0[1] * o0[1]) + (o0[2] * o0[2] + o0[3] * o0[3]) + (o1[0] * o1[0] + o1[1] * o1[1]) + (o1[2] * o1[2] + o1[3] * o1[3]); }
                sq += __shfl_xor(sq, 16); sq += __shfl_xor(sq, 32);
                if (fq == 0) *(g_f32*)(ssacc + (size_t)row * 16 + u.pn * 4 + wc) = sq;
                asm volatile("" ::: "memory"); }
    }
};

template <class Epi, class Sched, bool ALIGN_EPI = false, bool SP2 = false>
__device__ __forceinline__ void gemm_phase(PG8_LAS unsigned char* lds, const Gemm g, const Sched& S, const Epi& E) {
    int tid_ = threadIdx.x; asm volatile("" : "+v"(tid_));
    const int tid = tid_, wid = __builtin_amdgcn_readfirstlane(tid >> 6), lane = tid & 63, wr = wid >> 2, wc = wid & 3, fr = lane & 15, fq = lane >> 4;
    const int K = g.K, nt = K / BK;
    unsigned voffA[2], voffB[2];
#pragma unroll
    for (int i = 0; i < 2; ++i) { int R, C; stage_rc(tid * 16 + i * 8192, R, C); const int Rb = Epi::PERM ? ((R & ~31) + perm32(R & 31)) : R;
        voffA[i] = (unsigned)(R * K + C) * 2u; voffB[i] = (unsigned)(Rb * K + C) * 2u; }
    const size_t kstep = (size_t)(BK * 2);
    const size_t hstep = (size_t)HALF * K * 2;
    const size_t tstep = 2 * hstep;
    const unsigned ldsw = (unsigned)wid * 1024u;
    const int aoff = lds_byte(wr * 64 + fr, fq * 8), boff = lds_byte(wc * 32 + fr, fq * 8);
#define PG8_SA(b, h) (((b) * 2 + (h)) * HTB)
#define PG8_SB(b, h) ((4 + (b) * 2 + (h)) * HTB)
#define PG8_STAGE(bufoff, gbase, voff) do { _Pragma("unroll") for (int _i = 0; _i < 2; ++_i) \
        __builtin_amdgcn_global_load_lds((const unsigned*)((const char*)(gbase) + (voff)[_i]), (PG8_LAS unsigned*)(lds + (bufoff) + ldsw + _i * 8192), 16, 0, 0); } while (0)
#define PG8_LDA(dst, b, h) do { _Pragma("unroll") for (int m = 0; m < 4; ++m) _Pragma("unroll") for (int k = 0; k < 2; ++k) dst[m][k] = *(const PG8_LAS bf16x8*)(lds + PG8_SA(b, h) + aoff + m * 2048 + k * 1024); } while (0)
#define PG8_LDB(dst, b, h) do { _Pragma("unroll") for (int n = 0; n < 2; ++n) _Pragma("unroll") for (int k = 0; k < 2; ++k) dst[n][k] = *(const PG8_LAS bf16x8*)(lds + PG8_SB(b, h) + boff + n * 2048 + k * 1024); } while (0)
#define PG8_MMA(ai, bj, At, Bt) do { __builtin_amdgcn_s_setprio(1); _Pragma("unroll") for (int m = 0; m < 4; ++m) _Pragma("unroll") for (int n = 0; n < 2; ++n) _Pragma("unroll") for (int k = 0; k < 2; ++k) \
        acc[ai][bj][m][n] = __builtin_amdgcn_mfma_f32_16x16x32_bf16(Bt[n][k], At[m][k], acc[ai][bj][m][n], 0, 0, 0); __builtin_amdgcn_s_setprio(0); } while (0)
#define PG8_WAIT_V(n) asm volatile("s_waitcnt vmcnt(" #n ")" ::: "memory")
#define PG8_WAIT_L(n) asm volatile("s_waitcnt lgkmcnt(" #n ")" ::: "memory")
#define PG8_BAR __builtin_amdgcn_s_barrier()
#define PG8_SCHED __builtin_amdgcn_sched_barrier(0)
    Unit cur, nxt; int ui = 0;
    if (!S.next(0, cur)) return;
    f32x4 acc[2][2][4][2];
#pragma unroll
    for (int a = 0; a < 2; ++a)
#pragma unroll
        for (int b = 0; b < 2; ++b)
#pragma unroll
            for (int m = 0; m < 4; ++m)
#pragma unroll
                for (int n = 0; n < 2; ++n) acc[a][b][m][n] = (f32x4){0.f, 0.f, 0.f, 0.f};
    bf16x8 At[4][2], B0[2][2], B1[2][2];
    const char* cA = (const char*)g.A + (size_t)cur.pm * tstep; const char* cB = (const char*)g.Bt + (size_t)cur.pn * tstep;
    S.a_ready(cur);
    if constexpr (SP2) {
        PG8_STAGE(PG8_SB(0, 0), cB, voffB); PG8_STAGE(PG8_SB(0, 1), cB + hstep, voffB); PG8_STAGE(PG8_SA(0, 0), cA, voffA); PG8_STAGE(PG8_SA(0, 1), cA + hstep, voffA);
        if (wr == 1) PG8_BAR;
        PG8_WAIT_V(2); PG8_BAR;
        PG8_STAGE(PG8_SB(1, 0), cB + kstep, voffB); PG8_STAGE(PG8_SA(1, 0), cA + kstep, voffA); PG8_STAGE(PG8_SB(1, 1), cB + hstep + kstep, voffB);
        PG8_WAIT_V(6); PG8_BAR;
    } else {
        PG8_STAGE(PG8_SB(0, 0), cB, voffB); PG8_STAGE(PG8_SA(0, 0), cA, voffA); PG8_STAGE(PG8_SB(0, 1), cB + hstep, voffB); PG8_STAGE(PG8_SA(0, 1), cA + hstep, voffA);
        if (wr == 1) PG8_BAR;
        PG8_WAIT_V(4); PG8_BAR;
        PG8_STAGE(PG8_SB(1, 0), cB + kstep, voffB); PG8_STAGE(PG8_SA(1, 0), cA + kstep, voffA); PG8_STAGE(PG8_SB(1, 1), cB + hstep + kstep, voffB);
        PG8_WAIT_V(6); PG8_BAR;
    }
    for (;;) {
        const bool has_next = S.next(ui + 1, nxt);
        const char* nA = has_next ? (const char*)g.A + (size_t)nxt.pm * tstep : cA; const char* nB = has_next ? (const char*)g.Bt + (size_t)nxt.pn * tstep : cB;
        for (int t = 0; t < nt; t += 2) {
            const bool last = (t == nt - 2);
            const char* a1 = cA + (size_t)(t + 1) * kstep;
            const char* a2 = last ? nA : cA + (size_t)(t + 2) * kstep; const char* b2 = last ? nB : cB + (size_t)(t + 2) * kstep;
            const char* a3 = a2 + kstep; const char* b3 = b2 + kstep;
            if (last && has_next) S.a_ready(nxt);
            if constexpr (SP2) {
            PG8_LDB(B0, 0, 0); PG8_LDB(B1, 0, 1); PG8_SCHED; PG8_LDA(At, 0, 0); PG8_STAGE(PG8_SA(1, 1), a1 + hstep, voffA);
            PG8_WAIT_V(8); PG8_WAIT_L(0); PG8_BAR; PG8_MMA(0, 0, At, B0); PG8_MMA(0, 1, At, B1); PG8_BAR; PG8_SCHED;
            PG8_LDA(At, 0, 1); PG8_STAGE(PG8_SB(0, 0), b2, voffB); PG8_STAGE(PG8_SB(0, 1), b2 + hstep, voffB); PG8_STAGE(PG8_SA(0, 0), a2, voffA);
            PG8_WAIT_V(8); PG8_WAIT_L(0); PG8_BAR; PG8_MMA(1, 0, At, B0); PG8_MMA(1, 1, At, B1); PG8_BAR; PG8_SCHED;
            PG8_LDB(B0, 1, 0); PG8_LDB(B1, 1, 1); PG8_SCHED; PG8_LDA(At, 1, 0); PG8_STAGE(PG8_SA(0, 1), a2 + hstep, voffA);
            PG8_WAIT_V(8); PG8_WAIT_L(0); PG8_BAR; PG8_MMA(0, 0, At, B0); PG8_MMA(0, 1, At, B1); PG8_BAR; PG8_SCHED;
            PG8_LDA(At, 1, 1); PG8_STAGE(PG8_SB(1, 0), b3, voffB); PG8_STAGE(PG8_SB(1, 1), b3 + hstep, voffB); PG8_STAGE(PG8_SA(1, 0), a3, voffA);
            PG8_WAIT_V(8); PG8_WAIT_L(0); PG8_BAR; PG8_MMA(1, 0, At, B0); PG8_MMA(1, 1, At, B1); PG8_BAR; PG8_SCHED;
            } else {
            PG8_LDB(B0, 0, 0); PG8_SCHED; PG8_LDA(At, 0, 0); PG8_STAGE(PG8_SA(1, 1), a1 + hstep, voffA);
            PG8_WAIT_L(8); PG8_BAR; PG8_WAIT_L(0); PG8_MMA(0, 0, At, B0); PG8_BAR; PG8_SCHED;
            PG8_LDB(B1, 0, 1); PG8_STAGE(PG8_SB(0, 0), b2, voffB);
            PG8_BAR; PG8_WAIT_L(0); PG8_MMA(0, 1, At, B1); PG8_BAR;
            PG8_LDA(At, 0, 1); PG8_STAGE(PG8_SA(0, 0), a2, voffA);
            PG8_BAR; PG8_WAIT_L(0); PG8_MMA(1, 0, At, B0); PG8_BAR; PG8_SCHED;
            PG8_STAGE(PG8_SB(0, 1), b2 + hstep, voffB);
            PG8_WAIT_V(6); PG8_BAR; PG8_MMA(1, 1, At, B1); PG8_BAR;
            PG8_LDB(B0, 1, 0); PG8_SCHED; PG8_LDA(At, 1, 0); PG8_STAGE(PG8_SA(0, 1), a2 + hstep, voffA);
            PG8_WAIT_L(8); PG8_BAR; PG8_WAIT_L(0); PG8_MMA(0, 0, At, B0); PG8_BAR; PG8_SCHED;
            PG8_LDB(B1, 1, 1); PG8_STAGE(PG8_SB(1, 0), b3, voffB);
            PG8_BAR; PG8_WAIT_L(0); PG8_MMA(0, 1, At, B1); PG8_BAR;
            PG8_LDA(At, 1, 1); PG8_STAGE(PG8_SA(1, 0), a3, voffA);
            PG8_BAR; PG8_WAIT_L(0); PG8_MMA(1, 0, At, B0); PG8_BAR; PG8_SCHED;
            PG8_STAGE(PG8_SB(1, 1), b3 + hstep, voffB);
            PG8_WAIT_V(6); PG8_BAR; PG8_MMA(1, 1, At, B1); PG8_BAR;
            }
        }
        if constexpr (ALIGN_EPI) { if (wr == 0) PG8_BAR; }
        if constexpr (!Epi::AFTER_DRAIN) { E(acc, cur, wr, wc, fr, fq); S.done(cur); }
        if (!has_next) break;
#pragma unroll
        for (int a = 0; a < 2; ++a)
#pragma unroll
            for (int b = 0; b < 2; ++b)
#pragma unroll
                for (int m = 0; m < 4; ++m)
#pragma unroll
                    for (int n = 0; n < 2; ++n) acc[a][b][m][n] = (f32x4){0.f, 0.f, 0.f, 0.f};
        cur = nxt; cA = nA; cB = nB; ++ui;
        if constexpr (ALIGN_EPI) { if (wr == 1) PG8_BAR; }
    }
    PG8_WAIT_V(0);
    if constexpr (!ALIGN_EPI) { if (wr == 0) PG8_BAR; }
    PG8_BAR;
    if constexpr (Epi::AFTER_DRAIN) { E.fused(acc, cur, wr, wc, fr, fq, lds, wid, lane); S.done(cur); }
#undef PG8_SA
#undef PG8_SB
#undef PG8_STAGE
#undef PG8_LDA
#undef PG8_LDB
#undef PG8_MMA
#undef PG8_WAIT_V
#undef PG8_WAIT_L
#undef PG8_BAR
#undef PG8_SCHED
}
}

constexpr int NWAVES = 8, NTHR = 512;
constexpr int BATCH = 8, SEQ = 4096, DM = 1024, DEPTH = 4, DFF = 2816, NFFI = 2 * DFF, INW = 1792, NHEADS = 8, CONVW = 31, CCH = 512;
constexpr int M = BATCH * SEQ;
constexpr float EPS = 1e-6f, L2E = 1.4426950408889634f;
constexpr size_t MiB = 1u << 20;
constexpr size_t WS_SS = 0;
constexpr size_t WS_CTL = 2 * MiB;
constexpr size_t WS_W = 4 * MiB;
constexpr size_t W_FFI = (size_t)NFFI * DM * 2, W_FFO = (size_t)DM * DFF * 2, W_IN = (size_t)INW * DM * 2, W_OUT = (size_t)DM * DM * 2;
constexpr size_t WL_FI1 = 0, WL_FO1 = WL_FI1 + W_FFI, WL_IN = WL_FO1 + W_FFO, WL_OUT = WL_IN + W_IN, WL_FI2 = WL_OUT + W_OUT, WL_FO2 = WL_FI2 + W_FFI, WL_SIZE = WL_FO2 + W_FFO;
constexpr size_t WS_XB = 160 * MiB;
constexpr size_t WS_ACT = 224 * MiB;
constexpr size_t WS_QKV = WS_ACT, WS_Z = WS_QKV + (size_t)M * 768 * 2, WS_MIX = WS_Z + (size_t)M * 512 * 2;
constexpr size_t WS_END = WS_ACT + (size_t)M * DFF * 2;
static_assert(WS_W + DEPTH * WL_SIZE <= WS_XB && WS_XB + (size_t)M * DM * 2 <= WS_ACT && WS_MIX + (size_t)M * DM * 2 <= WS_END, "d_ws map");
constexpr int RING_BYTES = 131072, LDS_BYTES = 147456;
constexpr int REP_PRO = 1, REP_MIX = 1, XSYNC = 0, REP_FFI = 1, REP_INP = 1, REP_FFI_STREAM = 1, REP_ATT = 1;

#define GAS __attribute__((address_space(1)))
#define LAS __attribute__((address_space(3)))
typedef unsigned short bf16;
typedef unsigned v4u __attribute__((ext_vector_type(4)));
typedef float f32x4 __attribute__((ext_vector_type(4)));
typedef float f32x2 __attribute__((ext_vector_type(2)));
typedef float f32x16 __attribute__((ext_vector_type(16)));
typedef short bf16x8 __attribute__((ext_vector_type(8)));
typedef short s16x4 __attribute__((ext_vector_type(4)));
#define LDS_WAIT() asm volatile("s_waitcnt lgkmcnt(0)" ::: "memory")
__device__ __forceinline__ unsigned f2bf(float f) { unsigned u = __builtin_bit_cast(unsigned, f); return (u + 0x7fffu + ((u >> 16) & 1u)) >> 16; }
__device__ __forceinline__ unsigned pk2(float lo, float hi) { return f2bf(lo) | (f2bf(hi) << 16); }
__device__ __forceinline__ unsigned cvtpk(float lo, float hi) { typedef __bf16 bf2 __attribute__((ext_vector_type(2))); f32x2 v = {lo, hi}; return __builtin_bit_cast(unsigned, __builtin_convertvector(v, bf2)); }
__device__ __forceinline__ float wave_sum(float v) {
#pragma unroll
    for (int o = 1; o < 64; o <<= 1) v += __shfl_xor(v, o);
    return v;
}

template <int MAP> __device__ __forceinline__ int colmap(int np) {
    if (MAP == 1) { const int pn = np >> 8, bj = (np >> 7) & 1, jj = np & 127; return bj * DFF + pn * 128 + jj; }
    if (MAP == 2) { if (np < 768) return np; const int r = np - 768, t = r >> 8, bj = (r >> 7) & 1, jj = r & 127; return 768 + bj * CCH + t * 128 + jj; }
    return np;
}
struct Args { const float* in[16]; float* out; unsigned char* ws; };

struct TItem { const float* src; const float* gain; bf16* dst; int N, K; };
__device__ __forceinline__ TItem titem(const Args& a, int it, int lane) {
    constexpr int I_FI = (DM / 64) * (NFFI / 32), I_FO = (DFF / 64) * (DM / 32), I_IN = (DM / 64) * (INW / 32), I_OUT = (DM / 64) * (DM / 32);
    constexpr int I_LAYER = 2 * I_FI + 2 * I_FO + I_IN + I_OUT;
    const int l = it / I_LAYER; int r = it % I_LAYER;
    unsigned char* wl = a.ws + WS_W + (size_t)l * WL_SIZE;
    const float* W; const float* gain; bf16* WT; int K, N, map;
    if (r < I_FI) { W = a.in[2] + (size_t)l * DM * NFFI; gain = a.in[1] + l * DM; WT = (bf16*)(wl + WL_FI1); K = DM; N = NFFI; map = 1; }
    else if ((r -= I_FI) < I_FI) { W = a.in[13] + (size_t)l * DM * NFFI; gain = a.in[12] + l * DM; WT = (bf16*)(wl + WL_FI2); K = DM; N = NFFI; map = 1; }
    else if ((r -= I_FI) < I_FO) { W = a.in[3] + (size_t)l * DFF * DM; gain = nullptr; WT = (bf16*)(wl + WL_FO1); K = DFF; N = DM; map = 0; }
    else if ((r -= I_FO) < I_FO) { W = a.in[14] + (size_t)l * DFF * DM; gain = nullptr; WT = (bf16*)(wl + WL_FO2); K = DFF; N = DM; map = 0; }
    else if ((r -= I_FO) < I_IN) { W = a.in[5] + (size_t)l * DM * INW; gain = a.in[4] + l * DM; WT = (bf16*)(wl + WL_IN); K = DM; N = INW; map = 2; }
    else { r -= I_IN; W = a.in[11] + (size_t)l * DM * DM; gain = nullptr; WT = (bf16*)(wl + WL_OUT); K = DM; N = DM; map = 0; }
    const int nblk = N / 32, kb = r / nblk, nb = r % nblk, k0 = 64 * kb, n0 = 32 * nb;
    const int ns = map == 1 ? colmap<1>(n0) : map == 2 ? colmap<2>(n0) : n0;
    TItem t; t.src = W + (size_t)(k0 + (lane >> 5)) * N + ns + (lane & 31); t.gain = gain ? gain + k0 + lane : nullptr;
    t.dst = WT + (size_t)(n0 + (lane >> 3)) * K + k0 + 8 * (lane & 7); t.N = N; t.K = K; return t;
}
__device__ __forceinline__ void titem_load(const TItem& t, float (&v)[32], float& gv) {
#pragma unroll
    for (int i = 0; i < 32; ++i) v[i] = __builtin_nontemporal_load(t.src + (size_t)(2 * i) * t.N);
    gv = t.gain ? *t.gain : 1.0f;
}
__device__ __forceinline__ void titem_store(const TItem& t, const float (&v)[32], float gv, LAS float* scr, int lane) {
#pragma unroll
    for (int i = 0; i < 32; ++i) { const float g0 = __builtin_bit_cast(float, __builtin_amdgcn_readlane(__builtin_bit_cast(int, gv), 2 * i)), g1 = __builtin_bit_cast(float, __builtin_amdgcn_readlane(__builtin_bit_cast(int, gv), 2 * i + 1));
        scr[(2 * i + (lane >> 5)) * 33 + (lane & 31)] = v[i] * ((lane >> 5) ? g1 : g0); }
    LDS_WAIT(); asm volatile("" ::: "memory");
    const int c = lane & 7;
#pragma unroll
    for (int j = 0; j < 4; ++j) { const int n = (lane >> 3) + 8 * j; const LAS float* s = scr + (8 * c) * 33 + n;
        v4u o; o.x = pk2(s[0 * 33], s[1 * 33]); o.y = pk2(s[2 * 33], s[3 * 33]); o.z = pk2(s[4 * 33], s[5 * 33]); o.w = pk2(s[6 * 33], s[7 * 33]);
        *(GAS v4u*)(t.dst + (size_t)(8 * j) * t.K) = o; }
    LDS_WAIT(); asm volatile("" ::: "memory");
}

__device__ __forceinline__ void prologue(const Args& a, LAS unsigned char* lds, int wave, int lane, int G) {
    asm volatile("" : "+v"(lane));
    LAS float* scr = (LAS float*)(lds + wave * 16384);
    const int gw = blockIdx.x * NWAVES + wave, NGW = G * NWAVES;
    constexpr int I_TOTAL = DEPTH * (2 * (DM / 64) * (NFFI / 32) + 2 * (DFF / 64) * (DM / 32) + (DM / 64) * (INW / 32) + (DM / 64) * (DM / 32));
    if (gw < I_TOTAL) {
        TItem cur = titem(a, gw, lane); float v[32], w[32]; float gv, gw2 = 1.0f;
        titem_load(cur, v, gv);
        for (int it = gw; it < I_TOTAL; it += NGW) {
            const int nx = it + NGW; const bool more = nx < I_TOTAL; TItem nxt = cur;
            if (more) { nxt = titem(a, nx, lane); titem_load(nxt, w, gw2); }
            titem_store(cur, v, gv, scr, lane);
            if (more) {
#pragma unroll
                for (int i = 0; i < 32; ++i) v[i] = w[i];
                gv = gw2; cur = nxt; }
        }
    }
    float* ss = (float*)(a.ws + WS_SS); bf16* XB = (bf16*)(a.ws + WS_XB);
    for (int m = gw; m < M; m += 2 * NGW) {
        const int m2 = (m + NGW < M) ? m + NGW : m;
        const GAS f32x4* xr = (const GAS f32x4*)(a.in[0] + (size_t)m * DM) + lane; const GAS f32x4* xr2 = (const GAS f32x4*)(a.in[0] + (size_t)m2 * DM) + lane;
        f32x4 v[4], w[4]; float s = 0.f, s2 = 0.f;
#pragma unroll
        for (int j = 0; j < 4; ++j) { v[j] = __builtin_nontemporal_load(xr + 64 * j); w[j] = __builtin_nontemporal_load(xr2 + 64 * j); }
#pragma unroll
        for (int j = 0; j < 4; ++j) { s += (v[j].x * v[j].x + v[j].y * v[j].y) + (v[j].z * v[j].z + v[j].w * v[j].w); s2 += (w[j].x * w[j].x + w[j].y * w[j].y) + (w[j].z * w[j].z + w[j].w * w[j].w); }
        s = wave_sum(s); s2 = wave_sum(s2);
        GAS unsigned long long* o8 = (GAS unsigned long long*)(XB + (size_t)m * DM) + lane; GAS unsigned long long* p8 = (GAS unsigned long long*)(XB + (size_t)m2 * DM) + lane;
#pragma unroll
        for (int j = 0; j < 4; ++j) { o8[64 * j] = (unsigned long long)pk2(v[j].x, v[j].y) | ((unsigned long long)pk2(v[j].z, v[j].w) << 32);
            p8[64 * j] = (unsigned long long)pk2(w[j].x, w[j].y) | ((unsigned long long)pk2(w[j].z, w[j].w) << 32); }
        if (lane < 16) { ss[(size_t)m * 16 + lane] = lane == 0 ? s : 0.f; ss[(size_t)m2 * 16 + lane] = lane == 0 ? s2 : 0.f; }
    }
}

constexpr int AT_ROWB = 144, AT_VOFF = 256 * AT_ROWB;
__device__ __forceinline__ s16x4 vtr(const LAS unsigned char* p) { return __builtin_bit_cast(s16x4, __builtin_amdgcn_ds_read_tr16_b64_v4i16((LAS s16x4*)p)); }
__device__ __forceinline__ void attn_unit(LAS unsigned char* lds, int unit, const bf16* QKV, bf16* MIX, const float* sinks_l) {
    int tid = threadIdx.x; asm volatile("" : "+v"(tid));
    const int lane_ = tid & 63, wid = __builtin_amdgcn_readfirstlane(tid >> 6);
    const int kvh = unit & 1, n = (unit >> 1) & 31, b = unit >> 6;
    const size_t tok0 = (size_t)b * SEQ + (size_t)n * 128;
    const int hg = kvh * 4 + (wid >> 1);
    bf16x8 qa[2][4];
#pragma unroll
    for (int ii = 0; ii < 2; ++ii) { const bf16* qp = QKV + (tok0 + 32 * (2 * (wid & 1) + ii) + (lane_ & 31)) * 768 + hg * 64 + (lane_ >> 5) * 8;
#pragma unroll
        for (int d0 = 0; d0 < 4; ++d0) qa[ii][d0] = *(const bf16x8*)(qp + d0 * 16); }
#pragma unroll
    for (int i = 0; i < 4; ++i) { const int idx = tid + NTHR * i, row = idx >> 3, ch = idx & 7;
        v4u kv = (v4u){0u, 0u, 0u, 0u}, vv = kv;
        if (n > 0 || row >= 128) { const bf16* src = QKV + (tok0 + row - 128) * 768 + 512 + kvh * 64 + ch * 8; kv = *(const v4u*)src; vv = *(const v4u*)(src + 128); }
        *(LAS v4u*)(lds + row * AT_ROWB + ch * 16) = kv; *(LAS v4u*)(lds + AT_VOFF + row * AT_ROWB + ch * 16) = vv; }
    __syncthreads();
    const float slope2 = __builtin_amdgcn_exp2f(-(float)(hg + 1)) * L2E, sink2 = sinks_l[hg] * L2E;
#pragma unroll
    for (int ii = 0; ii < 2; ++ii) {
        int lane = lane_; asm volatile("" : "+v"(lane));
        const int r32 = lane & 31, hi = lane >> 5;
        const int i = 2 * (wid & 1) + ii;
        bf16x8 qr[4];
#pragma unroll
        for (int d0 = 0; d0 < 4; ++d0) qr[d0] = ii ? qa[1][d0] : qa[0][d0];
        f32x16 S[5];
#pragma unroll
        for (int t = 0; t < 5; ++t) { const LAS unsigned char* kp = lds + (32 * (i + t) + r32) * AT_ROWB + hi * 16;
#pragma unroll
            for (int e = 0; e < 16; ++e) S[t][e] = 0.f;
#pragma unroll
            for (int d0 = 0; d0 < 4; ++d0) { const bf16x8 kf = *(const LAS bf16x8*)(kp + d0 * 32); S[t] = __builtin_amdgcn_mfma_f32_32x32x16_bf16(kf, qr[d0], S[t], 0, 0, 0); } }
        const int rb = r32 - 4 * hi + 128, tl = 32 * i + r32; const unsigned lim = (unsigned)(n > 0 ? 127 : (tl < 127 ? tl : 127));
        float mx = sink2;
        const float nrb = -slope2 * (float)rb;
        if (n > 0) {
#pragma unroll
            for (int t = 0; t < 5; ++t)
#pragma unroll
                for (int r = 0; r < 16; ++r) { const int cst = 32 * t + (r & 3) + 8 * (r >> 2);
                    float s = (S[t][r] + nrb) + slope2 * (float)cst;
                    if (t == 0) s = (rb - cst <= 127) ? s : -1e30f;
                    if (t == 4) s = (rb - cst >= 0) ? s : -1e30f;
                    S[t][r] = s; mx = fmaxf(mx, s); }
        } else {
#pragma unroll
            for (int t = 0; t < 5; ++t)
#pragma unroll
                for (int r = 0; r < 16; ++r) { const int cst = 32 * t + (r & 3) + 8 * (r >> 2); const int dist = rb - cst;
                    const float s = ((unsigned)dist <= lim) ? (S[t][r] + nrb) + slope2 * (float)cst : -1e30f; S[t][r] = s; mx = fmaxf(mx, s); }
        }
        mx = fmaxf(mx, __shfl_xor(mx, 32));
        float l = 0.f;
#pragma unroll
        for (int t = 0; t < 5; ++t)
#pragma unroll
            for (int r = 0; r < 16; ++r) { const float p = __builtin_amdgcn_exp2f(S[t][r] - mx); S[t][r] = p; l += p; }
        l += __shfl_xor(l, 32); l += __builtin_amdgcn_exp2f(sink2 - mx);
        const float inv = 1.0f / l;
        f32x16 o0, o1;
#pragma unroll
        for (int e = 0; e < 16; ++e) { o0[e] = 0.f; o1[e] = 0.f; }
#pragma unroll
        for (int t = 0; t < 5; ++t)
#pragma unroll
            for (int s = 0; s < 2; ++s) {
                v4u pw; pw.x = cvtpk(S[t][8 * s + 0] * inv, S[t][8 * s + 1] * inv); pw.y = cvtpk(S[t][8 * s + 2] * inv, S[t][8 * s + 3] * inv);
                pw.z = cvtpk(S[t][8 * s + 4] * inv, S[t][8 * s + 5] * inv); pw.w = cvtpk(S[t][8 * s + 6] * inv, S[t][8 * s + 7] * inv);
                const bf16x8 pa = __builtin_bit_cast(bf16x8, pw);
                const LAS unsigned char* vp = lds + AT_VOFF + (32 * (i + t) + 16 * s + 4 * hi + ((lane & 15) >> 2)) * AT_ROWB + (16 * ((lane >> 4) & 1) + 4 * (lane & 3)) * 2;
                const s16x4 l0 = vtr(vp), h0 = vtr(vp + 8 * AT_ROWB), l1 = vtr(vp + 64), h1 = vtr(vp + 8 * AT_ROWB + 64);
                const bf16x8 v0 = (bf16x8){l0[0], l0[1], l0[2], l0[3], h0[0], h0[1], h0[2], h0[3]}, v1 = (bf16x8){l1[0], l1[1], l1[2], l1[3], h1[0], h1[1], h1[2], h1[3]};
                o0 = __builtin_amdgcn_mfma_f32_32x32x16_bf16(pa, v0, o0, 0, 0, 0); o1 = __builtin_amdgcn_mfma_f32_32x32x16_bf16(pa, v1, o1, 0, 0, 0); }
        bf16* op = MIX + (tok0 + 32 * i) * 1024 + hg * 64 + r32;
#pragma unroll
        for (int r = 0; r < 16; ++r) { const int q = (r & 3) + 8 * (r >> 2) + 4 * hi; const unsigned w2 = cvtpk(o0[r], o1[r]); op[(size_t)q * 1024] = (bf16)(w2 & 0xffffu); op[(size_t)q * 1024 + 32] = (bf16)(w2 >> 16); }
    }
    __syncthreads();
}

constexpr int CV_YOFF = 62 * 1024;
__device__ __forceinline__ void conv_unit(LAS unsigned char* lds, int cu, const bf16* Z, bf16* MIX, const float* wdw, const float* bdw, const float* lng, const float* lnb) {
    int tid = threadIdx.x; asm volatile("" : "+v"(tid));
    const int lane = tid & 63, wid = __builtin_amdgcn_readfirstlane(tid >> 6);
    const int b = cu >> 7, t0 = (cu & 127) * 32; const size_t tokb = (size_t)b * SEQ;
#pragma unroll
    for (int i = 0; i < 8; ++i) { const int idx = tid + NTHR * i;
        if (idx < 62 * 64) { const int row = idx >> 6, ch = idx & 63, t = t0 - 30 + row; v4u v = (v4u){0u, 0u, 0u, 0u};
            if (t >= 0) v = *(const v4u*)(Z + (tokb + t) * CCH + ch * 8);
            *(LAS v4u*)(lds + row * 1024 + ch * 16) = v; } }
    const int c2 = tid & 255, half = __builtin_amdgcn_readfirstlane(tid >> 8);
    f32x2 w2[CONVW];
#pragma unroll
    for (int k = 0; k < CONVW; ++k) w2[k] = *(const f32x2*)(wdw + k * CCH + 2 * c2);
    const f32x2 bb = *(const f32x2*)(bdw + 2 * c2);
    __syncthreads();
    {
        f32x2 ac[16];
#pragma unroll
        for (int o = 0; o < 16; ++o) ac[o] = bb;
        const LAS unsigned char* zp = lds + (16 * half) * 1024 + c2 * 4;
#pragma unroll
        for (int jj = 0; jj < 46; ++jj) { const unsigned zz = *(const LAS unsigned*)(zp + jj * 1024);
            const f32x2 z2 = (f32x2){__builtin_bit_cast(float, zz << 16), __builtin_bit_cast(float, zz & 0xffff0000u)};
#pragma unroll
            for (int o = 0; o < 16; ++o) { const int k = jj - o; if (k >= 0 && k < CONVW) ac[o] += w2[k] * z2; } }
        LAS float* yp = (LAS float*)(lds + CV_YOFF) + (16 * half) * CCH + 2 * c2;
#pragma unroll
        for (int o = 0; o < 16; ++o) *(LAS f32x2*)(yp + o * CCH) = ac[o];
    }
    __syncthreads();
    {
        const f32x4 g0 = *(const f32x4*)(lng + lane * 8), g1 = *(const f32x4*)(lng + lane * 8 + 4), b0 = *(const f32x4*)(lnb + lane * 8), b1 = *(const f32x4*)(lnb + lane * 8 + 4);
#pragma unroll
        for (int q = 0; q < 4; ++q) { const int tl = 4 * wid + q; const LAS float* yr = (const LAS float*)(lds + CV_YOFF) + tl * CCH + lane * 8;
            f32x4 v0 = *(const LAS f32x4*)yr, v1 = *(const LAS f32x4*)(yr + 4);
            const float mean = wave_sum((v0.x + v0.y) + (v0.z + v0.w) + (v1.x + v1.y) + (v1.z + v1.w)) * (1.0f / CCH);
            v0 = v0 - mean; v1 = v1 - mean;
            const float var = wave_sum((v0.x * v0.x + v0.y * v0.y) + (v0.z * v0.z + v0.w * v0.w) + (v1.x * v1.x + v1.y * v1.y) + (v1.z * v1.z + v1.w * v1.w)) * (1.0f / CCH);
            const float rstd = rsqrtf(var + EPS);
            v0 = v0 * rstd * g0 + b0; v1 = v1 * rstd * g1 + b1;
            float y[8] = {v0.x, v0.y, v0.z, v0.w, v1.x, v1.y, v1.z, v1.w};
#pragma unroll
            for (int e = 0; e < 8; ++e) y[e] = y[e] * __builtin_amdgcn_rcpf(1.0f + __builtin_amdgcn_exp2f(-L2E * y[e]));
            v4u o; o.x = pk2(y[0], y[1]); o.y = pk2(y[2], y[3]); o.z = pk2(y[4], y[5]); o.w = pk2(y[6], y[7]);
            *(v4u*)(MIX + (tokb + t0 + tl) * 1024 + 512 + lane * 8) = o; }
    }
    __syncthreads();
}

typedef GAS unsigned gu32;
#define XB_TMO      128
#define XB_XCNT(j)  (256  + 64 * (j))
#define XB_XSUB(j)  (1280 + 64 * (j))
#define XB_XGEN(j)  (2304 + 64 * (j))
#define XB_TOP      3328
#define XB_TOPGEN   3392
#define XCD_BAR_WORDS 3456
#define XB_SPIN_CAP (1u << 18)

__device__ __forceinline__ unsigned xb_ld(unsigned* p)              { return __hip_atomic_load(p, __ATOMIC_RELAXED, __HIP_MEMORY_SCOPE_AGENT); }
__device__ __forceinline__ unsigned xb_add(unsigned* p, unsigned v) { return __hip_atomic_fetch_add(p, v, __ATOMIC_RELAXED, __HIP_MEMORY_SCOPE_AGENT); }
__device__ __forceinline__ unsigned xb_xcc_id() { return (unsigned)__builtin_amdgcn_s_getreg((3 << 11) | 20) & 0xFu; }
#define XB_SPIN(cond, bar) do { unsigned _sp = 0; while (cond) { __builtin_amdgcn_s_sleep(1); \
    if ((++_sp & 255u) == 0u) { if (xb_ld(&(bar)[XB_TMO])) break; if (_sp > XB_SPIN_CAP) { atomicAdd(&(bar)[XB_TMO], 1u); break; } } } } while (0)

struct XcdBarrier {
    unsigned* bar; unsigned x;
    volatile LAS unsigned* st;
};

__device__ __forceinline__ XcdBarrier xcd_barrier_post(unsigned* bar, volatile LAS unsigned* st) {
    XcdBarrier b; b.bar = bar; b.x = xb_xcc_id(); b.st = st;
    if (threadIdx.x == 0) (void)xb_add(&bar[XB_XCNT(b.x)], 1u);
    return b;
}
__device__ __forceinline__ void xcd_barrier_complete(unsigned* bar, unsigned x, unsigned& nloc, unsigned& nx) {
    const unsigned G = gridDim.x * gridDim.y * gridDim.z;
    unsigned sum, cnt, mine, sp = 0u;
    for (;;) {
        sum = 0u; cnt = 0u; mine = 0u;
#pragma unroll
        for (unsigned j = 0; j < 16; ++j) { const unsigned c = xb_ld(&bar[XB_XCNT(j)]); sum += c; cnt += (c > 0u) ? 1u : 0u; }
        if (sum == G) { mine = xb_ld(&bar[XB_XCNT(x)]); break; }
        __builtin_amdgcn_s_sleep(1);
        if ((++sp & 255u) == 0u) { if (xb_ld(&bar[XB_TMO])) break; if (sp > XB_SPIN_CAP) { atomicAdd(&bar[XB_TMO], 1u); break; } }
    }
    nloc = mine > 0u ? mine : 1u; nx = cnt > 0u ? cnt : 1u;
}

__device__ __forceinline__ void xcd_barrier(const XcdBarrier& b) {
    asm volatile("s_waitcnt vmcnt(0)" ::: "memory");
    __syncthreads();
    if (threadIdx.x == 0) {
        unsigned* bar = b.bar;
        __builtin_amdgcn_s_waitcnt(0);
        unsigned nloc = b.st[0], nx = b.st[1];
        if (nloc == 0u) { xcd_barrier_complete(bar, b.x, nloc, nx); b.st[0] = nloc; b.st[1] = nx; }
        const unsigned old = xb_add(&bar[XB_XSUB(b.x)], 1u);
        const unsigned gen = old / nloc;
        if (old + 1u == (gen + 1u) * nloc) {
            __builtin_amdgcn_fence(__ATOMIC_RELEASE, "agent");
            asm volatile("s_waitcnt vmcnt(0)" ::: "memory");
            const unsigned og = xb_add(&bar[XB_TOP], 1u);
            const unsigned tg = og / nx;
            if (og + 1u == (tg + 1u) * nx) xb_add(&bar[XB_TOPGEN], 1u);
            else XB_SPIN(xb_ld(&bar[XB_TOPGEN]) == tg, bar);
            __builtin_amdgcn_fence(__ATOMIC_ACQUIRE, "agent");
            xb_add(&bar[XB_XGEN(b.x)], 1u);
            asm volatile("s_waitcnt vmcnt(0)" ::: "memory");
        } else {
            XB_SPIN(xb_ld(&bar[XB_XGEN(b.x)]) == gen, bar);
            __builtin_amdgcn_fence(__ATOMIC_ACQUIRE, "agent");
            asm volatile("s_waitcnt vmcnt(0)" ::: "memory");
        }
    }
    __syncthreads();
}

template <class T> __device__ __forceinline__ T* lnd(T* p) { GAS T* g = (GAS T*)p; asm volatile("" : "+s"(g)); return (T*)g; }
#define GRID_SYNC() xcd_barrier(bar)
#define CG_SYNC() do { asm volatile("s_waitcnt vmcnt(0) lgkmcnt(0)" ::: "memory"); __syncthreads(); grid.sync(); \
    __builtin_amdgcn_fence(__ATOMIC_ACQUIRE, "agent"); asm volatile("s_waitcnt vmcnt(0)" ::: "memory"); __syncthreads(); } while (0)
__global__ void __launch_bounds__(NTHR, 2) fwd_mega(Args a) {
    extern __shared__ __attribute__((aligned(16))) unsigned char lds_raw[];
    cg::grid_group grid = cg::this_grid();
    LAS unsigned char* lds = (LAS unsigned char*)lds_raw;
    const int tid = threadIdx.x, lane = tid & 63, wave = __builtin_amdgcn_readfirstlane(tid >> 6), G = gridDim.x;
    unsigned char* ws = a.ws;
    float* SS = (float*)(ws + WS_SS); bf16* XB = (bf16*)(ws + WS_XB); bf16* ACT = (bf16*)(ws + WS_ACT);
    bf16* QKV = (bf16*)(ws + WS_QKV); bf16* Z = (bf16*)(ws + WS_Z); bf16* MIX = (bf16*)(ws + WS_MIX);
    float* X = a.out;

    volatile LAS unsigned* bst = (volatile LAS unsigned*)(lds + RING_BYTES);
    if (tid < 2) bst[tid] = 0u;
    unsigned* barw = (unsigned*)(ws + WS_CTL);
    if (blockIdx.x == 0) for (int w = tid; w < XCD_BAR_WORDS; w += NTHR) barw[w] = 0u;
    for (int rep = 0; rep < REP_PRO; ++rep) { prologue(a, lds, wave, lane, G); CG_SYNC(); }
    const XcdBarrier bar = xcd_barrier_post(barw, bst);
    for (int rep = 0; rep < XSYNC; ++rep) GRID_SYNC();

    for (int l = 0; l < DEPTH; ++l) {
        unsigned char* wl = ws + WS_W + (size_t)l * WL_SIZE;
        for (int part = 0; part < 3; ++part) {
            if (part != 1) {
                const bf16* Wi = (const bf16*)(wl + (part == 0 ? WL_FI1 : WL_FI2)); const bf16* Wo = (const bf16*)(wl + (part == 0 ? WL_FO1 : WL_FO2));
                for (int rep = 0; rep < REP_FFI; ++rep) {
                    pg8::Gemm g{lnd(XB), lnd(Wi), M, NFFI, DM}; pg8::StaticOrder S; S.init(M, NFFI, G, (int)blockIdx.x, REP_FFI_STREAM);
                    pg8::EpiSwiGLU E{lnd(ACT), DFF, lnd(SS)};
                    pg8::gemm_phase<pg8::EpiSwiGLU, pg8::StaticOrder, true, true>(lds, g, S, E);
                    GRID_SYNC();
                }
                {
                    pg8::Gemm g{lnd(ACT), lnd(Wo), M, DM, DFF}; pg8::StaticOrder S; S.init(M, DM, G, (int)blockIdx.x);
                    pg8::EpiResid E{lnd(XB), lnd(SS), 0.5f};
                    pg8::gemm_phase<pg8::EpiResid, pg8::StaticOrder, true, true>(lds, g, S, E);
                }
                GRID_SYNC();
            } else {
                for (int rep = 0; rep < REP_INP; ++rep) {
                    pg8::Gemm g{lnd(XB), lnd((const bf16*)(wl + WL_IN)), M, INW, DM}; pg8::StaticOrder S; S.init(M, INW, G, (int)blockIdx.x);
                    pg8::EpiInProj E{lnd(QKV), lnd(Z), lnd(SS), 0.125f * L2E};
                    pg8::gemm_phase<pg8::EpiInProj, pg8::StaticOrder, true, true>(lds, g, S, E);
                    GRID_SYNC();
                }
                for (int rep = 0; rep < REP_MIX; ++rep)
                for (int u = blockIdx.x; u < 512 + 1024; u += G) {
                    if (u < 512) { for (int r2 = 0; r2 < REP_ATT; ++r2) attn_unit(lds, u, lnd(QKV), lnd(MIX), lnd(a.in[6] + l * NHEADS)); }
                    else conv_unit(lds, u - 512, lnd(Z), lnd(MIX), lnd(a.in[7] + (size_t)l * CONVW * CCH), lnd(a.in[8] + l * CCH), lnd(a.in[9] + l * CCH), lnd(a.in[10] + l * CCH));
                }
                GRID_SYNC();
                {
                    pg8::Gemm g{lnd(MIX), lnd((const bf16*)(wl + WL_OUT)), M, DM, DM}; pg8::StaticOrder S; S.init(M, DM, G, (int)blockIdx.x);
                    pg8::EpiResid E{lnd(XB), lnd(SS), 1.0f};
                    pg8::gemm_phase<pg8::EpiResid, pg8::StaticOrder, true, true>(lds, g, S, E);
                }
                GRID_SYNC();
            }
        }
    }
    {
        const float* ssf = lnd(SS); const float* gf = a.in[15]; const bf16* xbf = lnd(XB);
        int lane = tid & 63; asm volatile("" : "+v"(lane));
        const int gw = blockIdx.x * NWAVES + wave, NGW = G * NWAVES;
        f32x4 gv[4];
#pragma unroll
        for (int q = 0; q < 2; ++q) { gv[2 * q] = *((const f32x4*)gf + 2 * (lane + 64 * q)); gv[2 * q + 1] = *((const f32x4*)gf + 2 * (lane + 64 * q) + 1); }
        for (int m = gw; m < M; m += NGW) {
            const f32x4 pp = *(const f32x4*)(ssf + (size_t)m * 16 + 4 * (lane & 3)); float sq = (pp[0] + pp[1]) + (pp[2] + pp[3]); sq += __shfl_xor(sq, 1); sq += __shfl_xor(sq, 2);
            const float rs = rsqrtf(sq * (1.0f / DM) + EPS);
#pragma unroll
            for (int q = 0; q < 2; ++q) { const v4u xv = *((const v4u*)(xbf + (size_t)m * DM) + lane + 64 * q);
                const f32x4 x0 = (f32x4){__builtin_bit_cast(float, xv.x << 16), __builtin_bit_cast(float, xv.x & 0xffff0000u), __builtin_bit_cast(float, xv.y << 16), __builtin_bit_cast(float, xv.y & 0xffff0000u)};
                const f32x4 x1 = (f32x4){__builtin_bit_cast(float, xv.z << 16), __builtin_bit_cast(float, xv.z & 0xffff0000u), __builtin_bit_cast(float, xv.w << 16), __builtin_bit_cast(float, xv.w & 0xffff0000u)};
                f32x4* o = (f32x4*)(X + (size_t)m * DM) + 2 * (lane + 64 * q);
                o[0] = x0 * rs * gv[2 * q]; o[1] = x1 * rs * gv[2 * q + 1]; } }
    }
}

extern "C" void kernel_launch(void* const* d_in, const int* in_sizes, int n_in, void* d_out, int out_size, void* d_ws, size_t ws_size, hipStream_t stream) {
    static int grid = 0;
    if (grid == 0) {
        if (n_in != 16 || in_sizes[0] != M * DM || out_size != M * DM || ws_size < WS_END) { fprintf(stderr, "kernel_launch: unexpected shapes / workspace (n_in %d, ws %zu, need %zu)\n", n_in, ws_size, (size_t)WS_END); grid = -1; return; }
        int dev = 0, cus = 0, per_cu = 0;
        (void)hipGetDevice(&dev); (void)hipDeviceGetAttribute(&cus, hipDeviceAttributeMultiprocessorCount, dev);
        if (hipFuncSetAttribute((const void*)fwd_mega, hipFuncAttributeMaxDynamicSharedMemorySize, LDS_BYTES) != hipSuccess) { fprintf(stderr, "kernel_launch: hipFuncSetAttribute failed\n"); grid = -1; return; }
        if (hipOccupancyMaxActiveBlocksPerMultiprocessor(&per_cu, (const void*)fwd_mega, NTHR, LDS_BYTES) != hipSuccess || per_cu < 1) { fprintf(stderr, "kernel_launch: occupancy query says %d\n", per_cu); per_cu = 1; }
        (void)hipGetLastError();
        grid = cus * 1;
    }
    if (grid < 0) return;
    Args a{};
    for (int i = 0; i < 16; ++i) a.in[i] = (const float*)d_in[i];
    a.out = (float*)d_out; a.ws = (unsigned char*)d_ws;
    void* args[] = {&a};
    hipError_t e = hipLaunchCooperativeKernel((const void*)fwd_mega, dim3(grid), dim3(NTHR), args, LDS_BYTES, stream);
    if (e != hipSuccess) fprintf(stderr, "cooperative launch failed: %s (grid %d)\n", hipGetErrorString(e), grid);
}
```

```cpp
#include <hip/hip_runtime.h>
#include <hip/hip_cooperative_groups.h>
#include <cstdio>
#include <cstdint>
namespace cg = cooperative_groups;
namespace pg8 {
#define PG8_LAS __attribute__((address_space(3)))
typedef unsigned short bf16_t;
typedef short bf16x8 __attribute__((ext_vector_type(8)));
typedef float f32x4 __attribute__((ext_vector_type(4)));
typedef unsigned u32x4 __attribute__((ext_vector_type(4)));
constexpr int BM = 256, BK = 64, HALF = 128, HTB = HALF * BK * 2  , STAGE_BYTES = 8 * HTB, NXCD = 8, WGM = 4;

__host__ __device__ __forceinline__ int lds_byte(int r, int c) { const int st = (r >> 4) * 2 + (c >> 5), rr = r & 15, cc = c & 31, ob = rr * 64 + cc * 2; return st * 1024 + (ob ^ (((ob >> 9) & 1) << 5)); }
__host__ __device__ __forceinline__ void stage_rc(int b, int& R, int& C) { const int st = b / 1024, sb = b % 1024, swz = sb ^ (((sb >> 9) & 1) << 5); R = (st >> 1) * 16 + swz / 64; C = (st & 1) * 32 + (swz % 64) / 2; }
__host__ __device__ __forceinline__ int perm32(int rho) { const int n = rho >> 4, i = rho & 15; return 8 * (i >> 2) + 4 * n + (i & 3); }

struct Unit { int pm, pn; };
struct Gemm { const bf16_t* A; const bf16_t* Bt; int M, N, K; };

struct StaticOrder {
    int nM, nN, nwg, G, c, rep;
    __host__ __device__ void init(int M, int N, int G_, int c_, int rep_ = 1) { nM = M / BM; nN = N / BM; nwg = nM * nN; G = G_; c = c_; rep = rep_; }
    __host__ __device__ bool next(int i, Unit& u) const {
        const int R = (nwg + G - 1) / G; if (i >= R * rep) return false; i = i % R;
        const long L = (long)i * G + c; if (L >= nwg) return false;
        int wgid = (int)L; { const int q = nwg / NXCD, r = nwg % NXCD, xcd = wgid % NXCD, off = wgid / NXCD; wgid = (xcd < r ? xcd * (q + 1) : r * (q + 1) + (xcd - r) * q) + off; }
        const int nig = WGM * nN, gid = wgid / nig, fm = gid * WGM, gsz = (nM - fm) < WGM ? (nM - fm) : WGM;
        u.pm = fm + ((wgid % nig) % gsz); u.pn = (wgid % nig) / gsz; return true;
    }
    __device__ __forceinline__ void a_ready(const Unit&) const {}
    __device__ __forceinline__ void done(const Unit&) const {}
};

__device__ __forceinline__ unsigned cvt_pk_bf16(float lo, float hi) { unsigned r; asm volatile("v_cvt_pk_bf16_f32 %0, %1, %2" : "=v"(r) : "v"(lo), "v"(hi)); return r; }
typedef float f32x2 __attribute__((ext_vector_type(2)));
constexpr float RMS_EPS = 1e-6f, LOG2E = 1.4426950408889634f;
__device__ __forceinline__ float sigm(float g) { return __builtin_amdgcn_rcpf(1.0f + __builtin_amdgcn_exp2f(-LOG2E * g)); }
#define PG8_GAS __attribute__((address_space(1)))
typedef PG8_GAS u32x4 g_u32x4; typedef PG8_GAS const u32x4 gc_u32x4; typedef PG8_GAS const f32x4 gc_f32x4; typedef PG8_GAS float g_f32;
__device__ __forceinline__ void xsum_fq8(float (&v)[2][4]) {
#pragma unroll
    for (int step = 16; step <= 32; step <<= 1) {
        float t[2][4];
#pragma unroll
        for (int a = 0; a < 2; ++a)
#pragma unroll
            for (int m = 0; m < 4; ++m) t[a][m] = __shfl_xor(v[a][m], step);
        asm volatile("" : "+v"(t[0][0]), "+v"(t[0][1]), "+v"(t[0][2]), "+v"(t[0][3]), "+v"(t[1][0]), "+v"(t[1][1]), "+v"(t[1][2]), "+v"(t[1][3]));
#pragma unroll
        for (int a = 0; a < 2; ++a)
#pragma unroll
            for (int m = 0; m < 4; ++m) v[a][m] += t[a][m];
    }
}
__device__ __forceinline__ void row_rstd8(const float* ssp, int row0, int fq, float (&rs)[2][4]) {
    f32x4 p[2][4];
#pragma unroll
    for (int ai = 0; ai < 2; ++ai)
#pragma unroll
        for (int m = 0; m < 4; ++m) p[ai][m] = *(gc_f32x4*)(ssp + (size_t)(row0 + ai * HALF + m * 16) * 16 + 4 * fq);
    asm volatile("" : "+v"(p[0][0]), "+v"(p[0][1]), "+v"(p[0][2]), "+v"(p[0][3]), "+v"(p[1][0]), "+v"(p[1][1]), "+v"(p[1][2]), "+v"(p[1][3]));
#pragma unroll
    for (int ai = 0; ai < 2; ++ai)
#pragma unroll
        for (int m = 0; m < 4; ++m) rs[ai][m] = (p[ai][m][0] + p[ai][m][1]) + (p[ai][m][2] + p[ai][m][3]);
    xsum_fq8(rs);
#pragma unroll
    for (int ai = 0; ai < 2; ++ai)
#pragma unroll
        for (int m = 0; m < 4; ++m) rs[ai][m] = rsqrtf(rs[ai][m] * (1.0f / 1024.0f) + RMS_EPS);
}
struct EpiSwiGLU {
    static constexpr bool PERM = true, AFTER_DRAIN = false;
    bf16_t* O; int ldc; const float* ss;
    __device__ __forceinline__ void operator()(const f32x4 (&acc)[2][2][4][2], const Unit& u, int wr, int wc, int fr, int fq) const {
        const int row0 = u.pm * BM + wr * 64 + fr, col0 = u.pn * HALF + wc * 32 + 8 * fq;
        float rsv[2][4]; row_rstd8(ss, row0, fq, rsv);
#pragma unroll
        for (int ai = 0; ai < 2; ++ai)
#pragma unroll
            for (int m = 0; m < 4; ++m) { const int row = row0 + ai * HALF + m * 16; const float rs = rsv[ai][m];
                const float c1 = -LOG2E * rs, rs2 = rs * rs;
                float o[8];
#pragma unroll
                for (int n = 0; n < 2; ++n)
#pragma unroll
                    for (int e = 0; e < 4; ++e) { const float g = acc[ai][0][m][n][e], up = acc[ai][1][m][n][e];
                        const float r = __builtin_amdgcn_rcpf(1.0f + __builtin_amdgcn_exp2f(g * c1)); o[4 * n + e] = (g * up) * (r * rs2); }
                u32x4 w; w.x = cvt_pk_bf16(o[0], o[1]); w.y = cvt_pk_bf16(o[2], o[3]); w.z = cvt_pk_bf16(o[4], o[5]); w.w = cvt_pk_bf16(o[6], o[7]);
                *(g_u32x4*)(O + (size_t)row * ldc + col0) = w; }
    }
};
struct EpiInProj {
    static constexpr bool PERM = true, AFTER_DRAIN = false;
    bf16_t* QKV; bf16_t* Z; const float* ss; float qscale;
    __device__ __forceinline__ void operator()(const f32x4 (&acc)[2][2][4][2], const Unit& u, int wr, int wc, int fr, int fq) const {
        const int row0 = u.pm * BM + wr * 64 + fr;
        float rsv[2][4]; row_rstd8(ss, row0, fq, rsv);
        if (u.pn < 3) {
            const float sc = u.pn < 2 ? qscale : 1.0f; const int col0 = u.pn * BM + wc * 32 + 8 * fq;
#pragma unroll
            for (int ai = 0; ai < 2; ++ai)
#pragma unroll
                for (int m = 0; m < 4; ++m) { const int row = row0 + ai * HALF + m * 16; const float rs = rsv[ai][m] * sc;
#pragma unroll
                    for (int bj = 0; bj < 2; ++bj) { const f32x4 v0 = acc[ai][bj][m][0] * rs, v1 = acc[ai][bj][m][1] * rs;
                        u32x4 w; w.x = cvt_pk_bf16(v0[0], v0[1]); w.y = cvt_pk_bf16(v0[2], v0[3]); w.z = cvt_pk_bf16(v1[0], v1[1]); w.w = cvt_pk_bf16(v1[2], v1[3]);
                        *(g_u32x4*)(QKV + (size_t)row * 768 + col0 + bj * HALF) = w; } }
        } else {
            const int col0 = (u.pn - 3) * HALF + wc * 32 + 8 * fq;
#pragma unroll
            for (int ai = 0; ai < 2; ++ai)
#pragma unroll
                for (int m = 0; m < 4; ++m) { const int row = row0 + ai * HALF + m * 16; const float rs = rsv[ai][m];
                    float o[8];
#pragma unroll
                    for (int n = 0; n < 2; ++n)
#pragma unroll
                        for (int e = 0; e < 4; ++e) { const float a = acc[ai][0][m][n][e] * rs, g = acc[ai][1][m][n][e] * rs; o[4 * n + e] = a * sigm(g); }
                    u32x4 w; w.x = cvt_pk_bf16(o[0], o[1]); w.y = cvt_pk_bf16(o[2], o[3]); w.z = cvt_pk_bf16(o[4], o[5]); w.w = cvt_pk_bf16(o[6], o[7]);
                    *(g_u32x4*)(Z + (size_t)row * 512 + col0) = w; }
        }
    }
};
struct EpiResid {
    static constexpr bool PERM = true, AFTER_DRAIN = false;
    bf16_t* xb; float* ssacc; float scale;
    __device__ __forceinline__ void operator()(const f32x4 (&acc)[2][2][4][2], const Unit& u, int wr, int wc, int fr, int fq) const {
        const int row0 = u.pm * BM + wr * 64 + fr, col0 = u.pn * BM + wc * 32 + 8 * fq;
        float sqv[2][4];
#pragma unroll
        for (int ai = 0; ai < 2; ++ai)
#pragma unroll
            for (int m = 0; m < 4; ++m) { const int row = row0 + ai * HALF + m * 16; bf16_t* p = xb + (size_t)row * 1024 + col0; float sq = 0.f; (void)row;
                const u32x4 xv0 = *(gc_u32x4*)p, xv1 = *(gc_u32x4*)(p + HALF);
#pragma unroll
                for (int bj = 0; bj < 2; ++bj) { const u32x4 xv = bj ? xv1 : xv0;
                    const f32x4 x0 = (f32x4){__builtin_bit_cast(float, xv.x << 16), __builtin_bit_cast(float, xv.x & 0xffff0000u), __builtin_bit_cast(float, xv.y << 16), __builtin_bit_cast(float, xv.y & 0xffff0000u)};
                    const f32x4 x1 = (f32x4){__builtin_bit_cast(float, xv.z << 16), __builtin_bit_cast(float, xv.z & 0xffff0000u), __builtin_bit_cast(float, xv.w << 16), __builtin_bit_cast(float, xv.w & 0xffff0000u)};
                    const f32x4 o0 = x0 + acc[ai][bj][m][0] * scale, o1 = x1 + acc[ai][bj][m][1] * scale;
                    u32x4 w; w.x = cvt_pk_bf16(o0[0], o0[1]); w.y = cvt_pk_bf16(o0[2], o0[3]); w.z = cvt_pk_bf16(o1[0], o1[1]); w.w = cvt_pk_bf16(o1[2], o1[3]);
                    *(g_u32x4*)(p + bj * HALF) = w;
                    sq += (o0[0] * o0[0] + o0[1] * o0[1]) + (o0[2] * o0[2] + o0[3] * o0[3]) + (o1[0] * o1[0] + o1[1] * o1[1]) + (o1[2] * o1[2] + o1[3] * o1[3]); }
                sqv[ai][m] = sq;
                asm volatile("" ::: "memory"); }
        xsum_fq8(sqv);
        if (fq == 0) {
#pragma unroll
            for (int ai = 0; ai < 2; ++ai)
#pragma unroll
                for (int m = 0; m < 4; ++m) *(g_f32*)(ssacc + (size_t)(row0 + ai * HALF + m * 16) * 16 + u.pn * 4 + wc) = sqv[ai][m]; }
    }
};

template <class Epi, class Sched, bool ALIGN_EPI = false, bool SP2 = false>
__device__ __forceinline__ void gemm_phase(PG8_LAS unsigned char* lds, const Gemm g, const Sched& S, const Epi& E) {
    int tid_ = threadIdx.x; asm volatile("" : "+v"(tid_));
    const int tid = tid_, wid = __builtin_amdgcn_readfirstlane(tid >> 6), lane = tid & 63, wr = wid >> 2, wc = wid & 3, fr = lane & 15, fq = lane >> 4;
    const int K = g.K, nt = K / BK;
    unsigned voffA[2], voffB[2];
#pragma unroll
    for (int i = 0; i < 2; ++i) { int R, C; stage_rc(tid * 16 + i * 8192, R, C); const int Rb = Epi::PERM ? ((R & ~31) + perm32(R & 31)) : R;
        voffA[i] = (unsigned)(R * K + C) * 2u; voffB[i] = (unsigned)(Rb * K + C) * 2u; }
    const size_t kstep = (size_t)(BK * 2);
    const size_t hstep = (size_t)HALF * K * 2;
    const size_t tstep = 2 * hstep;
    const unsigned ldsw = (unsigned)wid * 1024u;
    const int aoff = lds_byte(wr * 64 + fr, fq * 8), boff = lds_byte(wc * 32 + fr, fq * 8);
#define PG8_SA(b, h) (((b) * 2 + (h)) * HTB)
#define PG8_SB(b, h) ((4 + (b) * 2 + (h)) * HTB)
#define PG8_STAGE(bufoff, gbase, voff) do { _Pragma("unroll") for (int _i = 0; _i < 2; ++_i) \
        __builtin_amdgcn_global_load_lds((const unsigned*)((const char*)(gbase) + (voff)[_i]), (PG8_LAS unsigned*)(lds + (bufoff) + ldsw + _i * 8192), 16, 0, 0); } while (0)
#define PG8_LDA(dst, b, h) do { _Pragma("unroll") for (int m = 0; m < 4; ++m) _Pragma("unroll") for (int k = 0; k < 2; ++k) dst[m][k] = *(const PG8_LAS bf16x8*)(lds + PG8_SA(b, h) + aoff + m * 2048 + k * 1024); } while (0)
#define PG8_LDB(dst, b, h) do { _Pragma("unroll") for (int n = 0; n < 2; ++n) _Pragma("unroll") for (int k = 0; k < 2; ++k) dst[n][k] = *(const PG8_LAS bf16x8*)(lds + PG8_SB(b, h) + boff + n * 2048 + k * 1024); } while (0)
#define PG8_MMA(ai, bj, At, Bt) do { __builtin_amdgcn_s_setprio(1); _Pragma("unroll") for (int m = 0; m < 4; ++m) _Pragma("unroll") for (int n = 0; n < 2; ++n) _Pragma("unroll") for (int k = 0; k < 2; ++k) \
        acc[ai][bj][m][n] = __builtin_amdgcn_mfma_f32_16x16x32_bf16(Bt[n][k], At[m][k], acc[ai][bj][m][n], 0, 0, 0); __builtin_amdgcn_s_setprio(0); } while (0)
#define PG8_WAIT_V(n) asm volatile("s_waitcnt vmcnt(" #n ")" ::: "memory")
#define PG8_WAIT_L(n) asm volatile("s_waitcnt lgkmcnt(" #n ")" ::: "memory")
#define PG8_BAR __builtin_amdgcn_s_barrier()
#define PG8_SCHED __builtin_amdgcn_sched_barrier(0)
    Unit cur, nxt; int ui = 0;
    if (!S.next(0, cur)) return;
    f32x4 acc[2][2][4][2];
#pragma unroll
    for (int a = 0; a < 2; ++a)
#pragma unroll
        for (int b = 0; b < 2; ++b)
#pragma unroll
            for (int m = 0; m < 4; ++m)
#pragma unroll
                for (int n = 0; n < 2; ++n) acc[a][b][m][n] = (f32x4){0.f, 0.f, 0.f, 0.f};
    bf16x8 At[4][2], B0[2][2], B1[2][2];
    const char* cA = (const char*)g.A + (size_t)cur.pm * tstep; const char* cB = (const char*)g.Bt + (size_t)cur.pn * tstep;
    S.a_ready(cur);
    if constexpr (SP2) {
        PG8_STAGE(PG8_SB(0, 0), cB, voffB); PG8_STAGE(PG8_SB(0, 1), cB + hstep, voffB); PG8_STAGE(PG8_SA(0, 0), cA, voffA); PG8_STAGE(PG8_SA(0, 1), cA + hstep, voffA);
        if (wr == 1) PG8_BAR;
        PG8_WAIT_V(2); PG8_BAR;
        PG8_STAGE(PG8_SB(1, 0), cB + kstep, voffB); PG8_STAGE(PG8_SA(1, 0), cA + kstep, voffA); PG8_STAGE(PG8_SB(1, 1), cB + hstep + kstep, voffB);
        PG8_WAIT_V(6); PG8_BAR;
    } else {
        PG8_STAGE(PG8_SB(0, 0), cB, voffB); PG8_STAGE(PG8_SA(0, 0), cA, voffA); PG8_STAGE(PG8_SB(0, 1), cB + hstep, voffB); PG8_STAGE(PG8_SA(0, 1), cA + hstep, voffA);
        if (wr == 1) PG8_BAR;
        PG8_WAIT_V(4); PG8_BAR;
        PG8_STAGE(PG8_SB(1, 0), cB + kstep, voffB); PG8_STAGE(PG8_SA(1, 0), cA + kstep, voffA); PG8_STAGE(PG8_SB(1, 1), cB + hstep + kstep, voffB);
        PG8_WAIT_V(6); PG8_BAR;
    }
    for (;;) {
        const bool has_next = S.next(ui + 1, nxt);
        const char* nA = has_next ? (const char*)g.A + (size_t)nxt.pm * tstep : cA; const char* nB = has_next ? (const char*)g.Bt + (size_t)nxt.pn * tstep : cB;
        for (int t = 0; t < nt; t += 2) {
            const bool last = (t == nt - 2);
            const char* a1 = cA + (size_t)(t + 1) * kstep;
            const char* a2 = last ? nA : cA + (size_t)(t + 2) * kstep; const char* b2 = last ? nB : cB + (size_t)(t + 2) * kstep;
            const char* a3 = a2 + kstep; const char* b3 = b2 + kstep;
            if (last && has_next) S.a_ready(nxt);
            if constexpr (SP2) {
            PG8_LDB(B0, 0, 0); PG8_LDB(B1, 0, 1); PG8_SCHED; PG8_LDA(At, 0, 0); PG8_STAGE(PG8_SA(1, 1), a1 + hstep, voffA);
            PG8_WAIT_V(8); PG8_WAIT_L(0); PG8_BAR; PG8_MMA(0, 0, At, B0); PG8_MMA(0, 1, At, B1); PG8_BAR; PG8_SCHED;
            PG8_LDA(At, 0, 1); PG8_STAGE(PG8_SB(0, 0), b2, voffB); PG8_STAGE(PG8_SB(0, 1), b2 + hstep, voffB); PG8_STAGE(PG8_SA(0, 0), a2, voffA);
            PG8_WAIT_V(8); PG8_WAIT_L(0); PG8_BAR; PG8_MMA(1, 0, At, B0); PG8_MMA(1, 1, At, B1); PG8_BAR; PG8_SCHED;
            PG8_LDB(B0, 1, 0); PG8_LDB(B1, 1, 1); PG8_SCHED; PG8_LDA(At, 1, 0); PG8_STAGE(PG8_SA(0, 1), a2 + hstep, voffA);
            PG8_WAIT_V(8); PG8_WAIT_L(0); PG8_BAR; PG8_MMA(0, 0, At, B0); PG8_MMA(0, 1, At, B1); PG8_BAR; PG8_SCHED;
            PG8_LDA(At, 1, 1); PG8_STAGE(PG8_SB(1, 0), b3, voffB); PG8_STAGE(PG8_SB(1, 1), b3 + hstep, voffB); PG8_STAGE(PG8_SA(1, 0), a3, voffA);
            PG8_WAIT_V(8); PG8_WAIT_L(0); PG8_BAR; PG8_MMA(1, 0, At, B0); PG8_MMA(1, 1, At, B1); PG8_BAR; PG8_SCHED;
            } else {
            PG8_LDB(B0, 0, 0); PG8_SCHED; PG8_LDA(At, 0, 0); PG8_STAGE(PG8_SA(1, 1), a1 + hstep, voffA);
            PG8_WAIT_L(8); PG8_BAR; PG8_WAIT_L(0); PG8_MMA(0, 0, At, B0); PG8_BAR; PG8_SCHED;
            PG8_LDB(B1, 0, 1); PG8_STAGE(PG8_SB(0, 0), b2, voffB);
            PG8_BAR; PG8_WAIT_L(0); PG8_MMA(0, 1, At, B1); PG8_BAR;
            PG8_LDA(At, 0, 1); PG8_STAGE(PG8_SA(0, 0), a2, voffA);
            PG8_BAR; PG8_WAIT_L(0); PG8_MMA(1, 0, At, B0); PG8_BAR; PG8_SCHED;
            PG8_STAGE(PG8_SB(0, 1), b2 + hstep, voffB);
            PG8_WAIT_V(6); PG8_BAR; PG8_MMA(1, 1, At, B1); PG8_BAR;
            PG8_LDB(B0, 1, 0); PG8_SCHED; PG8_LDA(At, 1, 0); PG8_STAGE(PG8_SA(0, 1), a2 + hstep, voffA);
            PG8_WAIT_L(8); PG8_BAR; PG8_WAIT_L(0); PG8_MMA(0, 0, At, B0); PG8_BAR; PG8_SCHED;
            PG8_LDB(B1, 1, 1); PG8_STAGE(PG8_SB(1, 0), b3, voffB);
            PG8_BAR; PG8_WAIT_L(0); PG8_MMA(0, 1, At, B1); PG8_BAR;
            PG8_LDA(At, 1, 1); PG8_STAGE(PG8_SA(1, 0), a3, voffA);
            PG8_BAR; PG8_WAIT_L(0); PG8_MMA(1, 0, At, B0); PG8_BAR; PG8_SCHED;
            PG8_STAGE(PG8_SB(1, 1), b3 + hstep, voffB);
            PG8_WAIT_V(6); PG8_BAR; PG8_MMA(1, 1, At, B1); PG8_BAR;
            }
        }
        if constexpr (ALIGN_EPI) { if (wr == 0) PG8_BAR; }
        if constexpr (!Epi::AFTER_DRAIN) { E(acc, cur, wr, wc, fr, fq); S.done(cur); }
        if (!has_next) break;
#pragma unroll
        for (int a = 0; a < 2; ++a)
#pragma unroll
            for (int b = 0; b < 2; ++b)
#pragma unroll
                for (int m = 0; m < 4; ++m)
#pragma unroll
                    for (int n = 0; n < 2; ++n) acc[a][b][m][n] = (f32x4){0.f, 0.f, 0.f, 0.f};
        cur = nxt; cA = nA; cB = nB; ++ui;
        if constexpr (ALIGN_EPI) { if (wr == 1) PG8_BAR; }
    }
    PG8_WAIT_V(0);
    if constexpr (!ALIGN_EPI) { if (wr == 0) PG8_BAR; }
    PG8_BAR;
    if constexpr (Epi::AFTER_DRAIN) { E.fused(acc, cur, wr, wc, fr, fq, lds, wid, lane); S.done(cur); }
#undef PG8_SA
#undef PG8_SB
#undef PG8_STAGE
#undef PG8_LDA
#undef PG8_LDB
#undef PG8_MMA
#undef PG8_WAIT_V
#undef PG8_WAIT_L
#undef PG8_BAR
#undef PG8_SCHED
}
}

constexpr int NWAVES = 8, NTHR = 512;
constexpr int BATCH = 8, SEQ = 4096, DM = 1024, DEPTH = 4, DFF = 2816, NFFI = 2 * DFF, INW = 1792, NHEADS = 8, CONVW = 31, CCH = 512;
constexpr int M = BATCH * SEQ;
constexpr float EPS = 1e-6f, L2E = 1.4426950408889634f;
constexpr size_t MiB = 1u << 20;
constexpr size_t WS_SS = 0;
constexpr size_t WS_CTL = 2 * MiB;
constexpr size_t WS_W = 4 * MiB;
constexpr size_t W_FFI = (size_t)NFFI * DM * 2, W_FFO = (size_t)DM * DFF * 2, W_IN = (size_t)INW * DM * 2, W_OUT = (size_t)DM * DM * 2;
constexpr size_t WL_FI1 = 0, WL_FO1 = WL_FI1 + W_FFI, WL_IN = WL_FO1 + W_FFO, WL_OUT = WL_IN + W_IN, WL_FI2 = WL_OUT + W_OUT, WL_FO2 = WL_FI2 + W_FFI, WL_SIZE = WL_FO2 + W_FFO;
constexpr size_t WS_XB = 160 * MiB;
constexpr size_t WS_ACT = 224 * MiB;
constexpr size_t WS_QKV = WS_ACT, WS_Z = WS_QKV + (size_t)M * 768 * 2, WS_MIX = WS_Z + (size_t)M * 512 * 2;
constexpr size_t WS_END = WS_ACT + (size_t)M * DFF * 2;
static_assert(WS_W + DEPTH * WL_SIZE <= WS_XB && WS_XB + (size_t)M * DM * 2 <= WS_ACT && WS_MIX + (size_t)M * DM * 2 <= WS_END, "d_ws map");
constexpr int RING_BYTES = 131072, LDS_BYTES = 147456;
constexpr int REP_PRO = 1, REP_MIX = 1, XSYNC = 0, REP_FFI = 1, REP_INP = 1, REP_FFI_STREAM = 1, REP_ATT = 1;

#define GAS __attribute__((address_space(1)))
#define LAS __attribute__((address_space(3)))
typedef unsigned short bf16;
typedef unsigned v4u __attribute__((ext_vector_type(4)));
typedef float f32x4 __attribute__((ext_vector_type(4)));
typedef float f32x2 __attribute__((ext_vector_type(2)));
typedef float f32x16 __attribute__((ext_vector_type(16)));
typedef short bf16x8 __attribute__((ext_vector_type(8)));
typedef short s16x4 __attribute__((ext_vector_type(4)));
#define LDS_WAIT() asm volatile("s_waitcnt lgkmcnt(0)" ::: "memory")
__device__ __forceinline__ unsigned f2bf(float f) { unsigned u = __builtin_bit_cast(unsigned, f); return (u + 0x7fffu + ((u >> 16) & 1u)) >> 16; }
__device__ __forceinline__ unsigned pk2(float lo, float hi) { return f2bf(lo) | (f2bf(hi) << 16); }
__device__ __forceinline__ unsigned cvtpk(float lo, float hi) { typedef __bf16 bf2 __attribute__((ext_vector_type(2))); f32x2 v = {lo, hi}; return __builtin_bit_cast(unsigned, __builtin_convertvector(v, bf2)); }
__device__ __forceinline__ float wave_sum(float v) {
#pragma unroll
    for (int o = 1; o < 64; o <<= 1) v += __shfl_xor(v, o);
    return v;
}

template <int MAP> __device__ __forceinline__ int colmap(int np) {
    if (MAP == 1) { const int pn = np >> 8, bj = (np >> 7) & 1, jj = np & 127; return bj * DFF + pn * 128 + jj; }
    if (MAP == 2) { if (np < 768) return np; const int r = np - 768, t = r >> 8, bj = (r >> 7) & 1, jj = r & 127; return 768 + bj * CCH + t * 128 + jj; }
    return np;
}
struct Args { const float* in[16]; float* out; unsigned char* ws; };

struct TItem { const float* src; const float* gain; bf16* dst; int N, K; };
__device__ __forceinline__ TItem titem(const Args& a, int it, int lane) {
    constexpr int I_FI = (DM / 64) * (NFFI / 32), I_FO = (DFF / 64) * (DM / 32), I_IN = (DM / 64) * (INW / 32), I_OUT = (DM / 64) * (DM / 32);
    constexpr int I_LAYER = 2 * I_FI + 2 * I_FO + I_IN + I_OUT;
    const int l = it / I_LAYER; int r = it % I_LAYER;
    unsigned char* wl = a.ws + WS_W + (size_t)l * WL_SIZE;
    const float* W; const float* gain; bf16* WT; int K, N, map;
    if (r < I_FI) { W = a.in[2] + (size_t)l * DM * NFFI; gain = a.in[1] + l * DM; WT = (bf16*)(wl + WL_FI1); K = DM; N = NFFI; map = 1; }
    else if ((r -= I_FI) < I_FI) { W = a.in[13] + (size_t)l * DM * NFFI; gain = a.in[12] + l * DM; WT = (bf16*)(wl + WL_FI2); K = DM; N = NFFI; map = 1; }
    else if ((r -= I_FI) < I_FO) { W = a.in[3] + (size_t)l * DFF * DM; gain = nullptr; WT = (bf16*)(wl + WL_FO1); K = DFF; N = DM; map = 0; }
    else if ((r -= I_FO) < I_FO) { W = a.in[14] + (size_t)l * DFF * DM; gain = nullptr; WT = (bf16*)(wl + WL_FO2); K = DFF; N = DM; map = 0; }
    else if ((r -= I_FO) < I_IN) { W = a.in[5] + (size_t)l * DM * INW; gain = a.in[4] + l * DM; WT = (bf16*)(wl + WL_IN); K = DM; N = INW; map = 2; }
    else { r -= I_IN; W = a.in[11] + (size_t)l * DM * DM; gain = nullptr; WT = (bf16*)(wl + WL_OUT); K = DM; N = DM; map = 0; }
    const int nblk = N / 32, kb = r / nblk, nb = r % nblk, k0 = 64 * kb, n0 = 32 * nb;
    const int ns = map == 1 ? colmap<1>(n0) : map == 2 ? colmap<2>(n0) : n0;
    TItem t; t.src = W + (size_t)(k0 + (lane >> 5)) * N + ns + (lane & 31); t.gain = gain ? gain + k0 + lane : nullptr;
    t.dst = WT + (size_t)(n0 + (lane >> 3)) * K + k0 + 8 * (lane & 7); t.N = N; t.K = K; return t;
}
__device__ __forceinline__ void titem_load(const TItem& t, float (&v)[32], float& gv) {
#pragma unroll
    for (int i = 0; i < 32; ++i) v[i] = __builtin_nontemporal_load(t.src + (size_t)(2 * i) * t.N);
    gv = t.gain ? *t.gain : 1.0f;
}
__device__ __forceinline__ void titem_store(const TItem& t, const float (&v)[32], float gv, LAS float* scr, int lane) {
#pragma unroll
    for (int i = 0; i < 32; ++i) { const float g0 = __builtin_bit_cast(float, __builtin_amdgcn_readlane(__builtin_bit_cast(int, gv), 2 * i)), g1 = __builtin_bit_cast(float, __builtin_amdgcn_readlane(__builtin_bit_cast(int, gv), 2 * i + 1));
        scr[(2 * i + (lane >> 5)) * 33 + (lane & 31)] = v[i] * ((lane >> 5) ? g1 : g0); }
    LDS_WAIT(); asm volatile("" ::: "memory");
    const int c = lane & 7;
#pragma unroll
    for (int j = 0; j < 4; ++j) { const int n = (lane >> 3) + 8 * j; const LAS float* s = scr + (8 * c) * 33 + n;
        v4u o; o.x = pk2(s[0 * 33], s[1 * 33]); o.y = pk2(s[2 * 33], s[3 * 33]); o.z = pk2(s[4 * 33], s[5 * 33]); o.w = pk2(s[6 * 33], s[7 * 33]);
        *(GAS v4u*)(t.dst + (size_t)(8 * j) * t.K) = o; }
    LDS_WAIT(); asm volatile("" ::: "memory");
}

__device__ __forceinline__ void prologue(const Args& a, LAS unsigned char* lds, int wave, int lane, int G) {
    asm volatile("" : "+v"(lane));
    LAS float* scr = (LAS float*)(lds + wave * 16384);
    const int gw = blockIdx.x * NWAVES + wave, NGW = G * NWAVES;
    constexpr int I_TOTAL = DEPTH * (2 * (DM / 64) * (NFFI / 32) + 2 * (DFF / 64) * (DM / 32) + (DM / 64) * (INW / 32) + (DM / 64) * (DM / 32));
    if (gw < I_TOTAL) {
        TItem cur = titem(a, gw, lane); float v[32], w[32]; float gv, gw2 = 1.0f;
        titem_load(cur, v, gv);
        for (int it = gw; it < I_TOTAL; it += NGW) {
            const int nx = it + NGW; const bool more = nx < I_TOTAL; TItem nxt = cur;
            if (more) { nxt = titem(a, nx, lane); titem_load(nxt, w, gw2); }
            titem_store(cur, v, gv, scr, lane);
            if (more) {
#pragma unroll
                for (int i = 0; i < 32; ++i) v[i] = w[i];
                gv = gw2; cur = nxt; }
        }
    }
    float* ss = (float*)(a.ws + WS_SS); bf16* XB = (bf16*)(a.ws + WS_XB);
    for (int m = gw; m < M; m += 2 * NGW) {
        const int m2 = (m + NGW < M) ? m + NGW : m;
        const GAS f32x4* xr = (const GAS f32x4*)(a.in[0] + (size_t)m * DM) + lane; const GAS f32x4* xr2 = (const GAS f32x4*)(a.in[0] + (size_t)m2 * DM) + lane;
        f32x4 v[4], w[4]; float s = 0.f, s2 = 0.f;
#pragma unroll
        for (int j = 0; j < 4; ++j) { v[j] = __builtin_nontemporal_load(xr + 64 * j); w[j] = __builtin_nontemporal_load(xr2 + 64 * j); }
#pragma unroll
        for (int j = 0; j < 4; ++j) { s += (v[j].x * v[j].x + v[j].y * v[j].y) + (v[j].z * v[j].z + v[j].w * v[j].w); s2 += (w[j].x * w[j].x + w[j].y * w[j].y) + (w[j].z * w[j].z + w[j].w * w[j].w); }
        s = wave_sum(s); s2 = wave_sum(s2);
        GAS unsigned long long* o8 = (GAS unsigned long long*)(XB + (size_t)m * DM) + lane; GAS unsigned long long* p8 = (GAS unsigned long long*)(XB + (size_t)m2 * DM) + lane;
#pragma unroll
        for (int j = 0; j < 4; ++j) { o8[64 * j] = (unsigned long long)pk2(v[j].x, v[j].y) | ((unsigned long long)pk2(v[j].z, v[j].w) << 32);
            p8[64 * j] = (unsigned long long)pk2(w[j].x, w[j].y) | ((unsigned long long)pk2(w[j].z, w[j].w) << 32); }
        if (lane < 16) { ss[(size_t)m * 16 + lane] = lane == 0 ? s : 0.f; ss[(size_t)m2 * 16 + lane] = lane == 0 ? s2 : 0.f; }
    }
}

constexpr int AT_ROWB = 144, AT_VOFF = 256 * AT_ROWB;
__device__ __forceinline__ s16x4 vtr(const LAS unsigned char* p) { return __builtin_bit_cast(s16x4, __builtin_amdgcn_ds_read_tr16_b64_v4i16((LAS s16x4*)p)); }
__device__ __forceinline__ void attn_unit(LAS unsigned char* lds, int unit, const bf16* QKV, bf16* MIX, const float* sinks_l) {
    int tid = threadIdx.x; asm volatile("" : "+v"(tid));
    const int lane_ = tid & 63, wid = __builtin_amdgcn_readfirstlane(tid >> 6);
    const int kvh = unit & 1, n = (unit >> 1) & 31, b = unit >> 6;
    const size_t tok0 = (size_t)b * SEQ + (size_t)n * 128;
    const int hg = kvh * 4 + (wid >> 1);
    bf16x8 qa[2][4];
#pragma unroll
    for (int ii = 0; ii < 2; ++ii) { const bf16* qp = QKV + (tok0 + 32 * (2 * (wid & 1) + ii) + (lane_ & 31)) * 768 + hg * 64 + (lane_ >> 5) * 8;
#pragma unroll
        for (int d0 = 0; d0 < 4; ++d0) qa[ii][d0] = *(const bf16x8*)(qp + d0 * 16); }
#pragma unroll
    for (int i = 0; i < 4; ++i) { const int idx = tid + NTHR * i, row = idx >> 3, ch = idx & 7;
        v4u kv = (v4u){0u, 0u, 0u, 0u}, vv = kv;
        if (n > 0 || row >= 128) { const bf16* src = QKV + (tok0 + row - 128) * 768 + 512 + kvh * 64 + ch * 8; kv = *(const v4u*)src; vv = *(const v4u*)(src + 128); }
        *(LAS v4u*)(lds + row * AT_ROWB + ch * 16) = kv; *(LAS v4u*)(lds + AT_VOFF + row * AT_ROWB + ch * 16) = vv; }
    __syncthreads();
    const float slope2 = __builtin_amdgcn_exp2f(-(float)(hg + 1)) * L2E, sink2 = sinks_l[hg] * L2E;
#pragma unroll
    for (int ii = 0; ii < 2; ++ii) {
        int lane = lane_; asm volatile("" : "+v"(lane));
        const int r32 = lane & 31, hi = lane >> 5;
        const int i = 2 * (wid & 1) + ii;
        bf16x8 qr[4];
#pragma unroll
        for (int d0 = 0; d0 < 4; ++d0) qr[d0] = ii ? qa[1][d0] : qa[0][d0];
        f32x16 S[5];
#pragma unroll
        for (int t = 0; t < 5; ++t) { const LAS unsigned char* kp = lds + (32 * (i + t) + r32) * AT_ROWB + hi * 16;
#pragma unroll
            for (int e = 0; e < 16; ++e) S[t][e] = 0.f;
#pragma unroll
            for (int d0 = 0; d0 < 4; ++d0) { const bf16x8 kf = *(const LAS bf16x8*)(kp + d0 * 32); S[t] = __builtin_amdgcn_mfma_f32_32x32x16_bf16(kf, qr[d0], S[t], 0, 0, 0); } }
        const int rb = r32 - 4 * hi + 128, tl = 32 * i + r32; const unsigned lim = (unsigned)(n > 0 ? 127 : (tl < 127 ? tl : 127));
        float mx = sink2;
        const float nrb = -slope2 * (float)rb;
        if (n > 0) {
#pragma unroll
            for (int t = 0; t < 5; ++t)
#pragma unroll
                for (int r = 0; r < 16; ++r) { const int cst = 32 * t + (r & 3) + 8 * (r >> 2);
                    float s = (S[t][r] + nrb) + slope2 * (float)cst;
                    if (t == 0) s = (rb - cst <= 127) ? s : -1e30f;
                    if (t == 4) s = (rb - cst >= 0) ? s : -1e30f;
                    S[t][r] = s; mx = fmaxf(mx, s); }
        } else {
#pragma unroll
            for (int t = 0; t < 5; ++t)
#pragma unroll
                for (int r = 0; r < 16; ++r) { const int cst = 32 * t + (r & 3) + 8 * (r >> 2); const int dist = rb - cst;
                    const float s = ((unsigned)dist <= lim) ? (S[t][r] + nrb) + slope2 * (float)cst : -1e30f; S[t][r] = s; mx = fmaxf(mx, s); }
        }
        mx = fmaxf(mx, __shfl_xor(mx, 32));
        float l = 0.f;
#pragma unroll
        for (int t = 0; t < 5; ++t)
#pragma unroll
            for (int r = 0; r < 16; ++r) { const float p = __builtin_amdgcn_exp2f(S[t][r] - mx); S[t][r] = p; l += p; }
        l += __shfl_xor(l, 32); l += __builtin_amdgcn_exp2f(sink2 - mx);
        const float inv = 1.0f / l;
        f32x16 o0, o1;
#pragma unroll
        for (int e = 0; e < 16; ++e) { o0[e] = 0.f; o1[e] = 0.f; }
#pragma unroll
        for (int t = 0; t < 5; ++t)
#pragma unroll
            for (int s = 0; s < 2; ++s) {
                v4u pw; pw.x = cvtpk(S[t][8 * s + 0] * inv, S[t][8 * s + 1] * inv); pw.y = cvtpk(S[t][8 * s + 2] * inv, S[t][8 * s + 3] * inv);
                pw.z = cvtpk(S[t][8 * s + 4] * inv, S[t][8 * s + 5] * inv); pw.w = cvtpk(S[t][8 * s + 6] * inv, S[t][8 * s + 7] * inv);
                const bf16x8 pa = __builtin_bit_cast(bf16x8, pw);
                const LAS unsigned char* vp = lds + AT_VOFF + (32 * (i + t) + 16 * s + 4 * hi + ((lane & 15) >> 2)) * AT_ROWB + (16 * ((lane >> 4) & 1) + 4 * (lane & 3)) * 2;
                const s16x4 l0 = vtr(vp), h0 = vtr(vp + 8 * AT_ROWB), l1 = vtr(vp + 64), h1 = vtr(vp + 8 * AT_ROWB + 64);
                const bf16x8 v0 = (bf16x8){l0[0], l0[1], l0[2], l0[3], h0[0], h0[1], h0[2], h0[3]}, v1 = (bf16x8){l1[0], l1[1], l1[2], l1[3], h1[0], h1[1], h1[2], h1[3]};
                o0 = __builtin_amdgcn_mfma_f32_32x32x16_bf16(pa, v0, o0, 0, 0, 0); o1 = __builtin_amdgcn_mfma_f32_32x32x16_bf16(pa, v1, o1, 0, 0, 0); }
        bf16* op = MIX + (tok0 + 32 * i) * 1024 + hg * 64 + r32;
#pragma unroll
        for (int r = 0; r < 16; ++r) { const int q = (r & 3) + 8 * (r >> 2) + 4 * hi; const unsigned w2 = cvtpk(o0[r], o1[r]); op[(size_t)q * 1024] = (bf16)(w2 & 0xffffu); op[(size_t)q * 1024 + 32] = (bf16)(w2 >> 16); }
    }
    __syncthreads();
}

constexpr int CV_YOFF = 62 * 1024;
__device__ __forceinline__ void conv_unit(LAS unsigned char* lds, int cu, const bf16* Z, bf16* MIX, const float* wdw, const float* bdw, const float* lng, const float* lnb) {
    int tid = threadIdx.x; asm volatile("" : "+v"(tid));
    const int lane = tid & 63, wid = __builtin_amdgcn_readfirstlane(tid >> 6);
    const int b = cu >> 7, t0 = (cu & 127) * 32; const size_t tokb = (size_t)b * SEQ;
#pragma unroll
    for (int i = 0; i < 8; ++i) { const int idx = tid + NTHR * i;
        if (idx < 62 * 64) { const int row = idx >> 6, ch = idx & 63, t = t0 - 30 + row; v4u v = (v4u){0u, 0u, 0u, 0u};
            if (t >= 0) v = *(const v4u*)(Z + (tokb + t) * CCH + ch * 8);
            *(LAS v4u*)(lds + row * 1024 + ch * 16) = v; } }
    const int c2 = tid & 255, half = __builtin_amdgcn_readfirstlane(tid >> 8);
    f32x2 w2[CONVW];
#pragma unroll
    for (int k = 0; k < CONVW; ++k) w2[k] = *(const f32x2*)(wdw + k * CCH + 2 * c2);
    const f32x2 bb = *(const f32x2*)(bdw + 2 * c2);
    __syncthreads();
    {
        f32x2 ac[16];
#pragma unroll
        for (int o = 0; o < 16; ++o) ac[o] = bb;
        const LAS unsigned char* zp = lds + (16 * half) * 1024 + c2 * 4;
#pragma unroll
        for (int jj = 0; jj < 46; ++jj) { const unsigned zz = *(const LAS unsigned*)(zp + jj * 1024);
            const f32x2 z2 = (f32x2){__builtin_bit_cast(float, zz << 16), __builtin_bit_cast(float, zz & 0xffff0000u)};
#pragma unroll
            for (int o = 0; o < 16; ++o) { const int k = jj - o; if (k >= 0 && k < CONVW) ac[o] += w2[k] * z2; } }
        LAS float* yp = (LAS float*)(lds + CV_YOFF) + (16 * half) * CCH + 2 * c2;
#pragma unroll
        for (int o = 0; o < 16; ++o) *(LAS f32x2*)(yp + o * CCH) = ac[o];
    }
    __syncthreads();
    {
        const f32x4 g0 = *(const f32x4*)(lng + lane * 8), g1 = *(const f32x4*)(lng + lane * 8 + 4), b0 = *(const f32x4*)(lnb + lane * 8), b1 = *(const f32x4*)(lnb + lane * 8 + 4);
#pragma unroll
        for (int q = 0; q < 4; ++q) { const int tl = 4 * wid + q; const LAS float* yr = (const LAS float*)(lds + CV_YOFF) + tl * CCH + lane * 8;
            f32x4 v0 = *(const LAS f32x4*)yr, v1 = *(const LAS f32x4*)(yr + 4);
            const float mean = wave_sum((v0.x + v0.y) + (v0.z + v0.w) + (v1.x + v1.y) + (v1.z + v1.w)) * (1.0f / CCH);
            v0 = v0 - mean; v1 = v1 - mean;
            const float var = wave_sum((v0.x * v0.x + v0.y * v0.y) + (v0.z * v0.z + v0.w * v0.w) + (v1.x * v1.x + v1.y * v1.y) + (v1.z * v1.z + v1.w * v1.w)) * (1.0f / CCH);
            const float rstd = rsqrtf(var + EPS);
            v0 = v0 * rstd * g0 + b0; v1 = v1 * rstd * g1 + b1;
            float y[8] = {v0.x, v0.y, v0.z, v0.w, v1.x, v1.y, v1.z, v1.w};
#pragma unroll
            for (int e = 0; e < 8; ++e) y[e] = y[e] * __builtin_amdgcn_rcpf(1.0f + __builtin_amdgcn_exp2f(-L2E * y[e]));
            v4u o; o.x = pk2(y[0], y[1]); o.y = pk2(y[2], y[3]); o.z = pk2(y[4], y[5]); o.w = pk2(y[6], y[7]);
            *(v4u*)(MIX + (tokb + t0 + tl) * 1024 + 512 + lane * 8) = o; }
    }
    __syncthreads();
}

typedef GAS unsigned gu32;
#define XB_TMO      128
#define XB_XCNT(j)  (256  + 64 * (j))
#define XB_XSUB(j)  (1280 + 64 * (j))
#define XB_XGEN(j)  (2304 + 64 * (j))
#define XB_TOP      3328
#define XB_TOPGEN   3392
#define XCD_BAR_WORDS 3456
#define XB_SPIN_CAP (1u << 18)

__device__ __forceinline__ unsigned xb_ld(unsigned* p)              { return __hip_atomic_load(p, __ATOMIC_RELAXED, __HIP_MEMORY_SCOPE_AGENT); }
__device__ __forceinline__ unsigned xb_add(unsigned* p, unsigned v) { return __hip_atomic_fetch_add(p, v, __ATOMIC_RELAXED, __HIP_MEMORY_SCOPE_AGENT); }
__device__ __forceinline__ unsigned xb_xcc_id() { return (unsigned)__builtin_amdgcn_s_getreg((3 << 11) | 20) & 0xFu; }
#define XB_SPIN(cond, bar) do { unsigned _sp = 0; while (cond) { __builtin_amdgcn_s_sleep(1); \
    if ((++_sp & 255u) == 0u) { if (xb_ld(&(bar)[XB_TMO])) break; if (_sp > XB_SPIN_CAP) { atomicAdd(&(bar)[XB_TMO], 1u); break; } } } } while (0)

struct XcdBarrier {
    unsigned* bar; unsigned x;
    volatile LAS unsigned* st;
};

__device__ __forceinline__ XcdBarrier xcd_barrier_post(unsigned* bar, volatile LAS unsigned* st) {
    XcdBarrier b; b.bar = bar; b.x = xb_xcc_id(); b.st = st;
    if (threadIdx.x == 0) (void)xb_add(&bar[XB_XCNT(b.x)], 1u);
    return b;
}
__device__ __forceinline__ void xcd_barrier_complete(unsigned* bar, unsigned x, unsigned& nloc, unsigned& nx) {
    const unsigned G = gridDim.x * gridDim.y * gridDim.z;
    unsigned sum, cnt, mine, sp = 0u;
    for (;;) {
        sum = 0u; cnt = 0u; mine = 0u;
#pragma unroll
        for (unsigned j = 0; j < 16; ++j) { const unsigned c = xb_ld(&bar[XB_XCNT(j)]); sum += c; cnt += (c > 0u) ? 1u : 0u; }
        if (sum == G) { mine = xb_ld(&bar[XB_XCNT(x)]); break; }
        __builtin_amdgcn_s_sleep(1);
        if ((++sp & 255u) == 0u) { if (xb_ld(&bar[XB_TMO])) break; if (sp > XB_SPIN_CAP) { atomicAdd(&bar[XB_TMO], 1u); break; } }
    }
    nloc = mine > 0u ? mine : 1u; nx = cnt > 0u ? cnt : 1u;
}

__device__ __forceinline__ void xcd_barrier(const XcdBarrier& b) {
    asm volatile("s_waitcnt vmcnt(0)" ::: "memory");
    __syncthreads();
    if (threadIdx.x == 0) {
        unsigned* bar = b.bar;
        __builtin_amdgcn_s_waitcnt(0);
        unsigned nloc = b.st[0], nx = b.st[1];
        if (nloc == 0u) { xcd_barrier_complete(bar, b.x, nloc, nx); b.st[0] = nloc; b.st[1] = nx; }
        const unsigned old = xb_add(&bar[XB_XSUB(b.x)], 1u);
        const unsigned gen = old / nloc;
        if (old + 1u == (gen + 1u) * nloc) {
            __builtin_amdgcn_fence(__ATOMIC_RELEASE, "agent");
            asm volatile("s_waitcnt vmcnt(0)" ::: "memory");
            const unsigned og = xb_add(&bar[XB_TOP], 1u);
            const unsigned tg = og / nx;
            if (og + 1u == (tg + 1u) * nx) xb_add(&bar[XB_TOPGEN], 1u);
            else XB_SPIN(xb_ld(&bar[XB_TOPGEN]) == tg, bar);
            __builtin_amdgcn_fence(__ATOMIC_ACQUIRE, "agent");
            xb_add(&bar[XB_XGEN(b.x)], 1u);
            asm volatile("s_waitcnt vmcnt(0)" ::: "memory");
        } else {
            XB_SPIN(xb_ld(&bar[XB_XGEN(b.x)]) == gen, bar);
            __builtin_amdgcn_fence(__ATOMIC_ACQUIRE, "agent");
            asm volatile("s_waitcnt vmcnt(0)" ::: "memory");
        }
    }
    __syncthreads();
}

template <class T> __device__ __forceinline__ T* lnd(T* p) { GAS T* g = (GAS T*)p; asm volatile("" : "+s"(g)); return (T*)g; }
#define GRID_SYNC() xcd_barrier(bar)
#define CG_SYNC() do { asm volatile("s_waitcnt vmcnt(0) lgkmcnt(0)" ::: "memory"); __syncthreads(); grid.sync(); \
    __builtin_amdgcn_fence(__ATOMIC_ACQUIRE, "agent"); asm volatile("s_waitcnt vmcnt(0)" ::: "memory"); __syncthreads(); } while (0)
__global__ void __launch_bounds__(NTHR, 2) fwd_mega(Args a) {
    extern __shared__ __attribute__((aligned(16))) unsigned char lds_raw[];
    cg::grid_group grid = cg::this_grid();
    LAS unsigned char* lds = (LAS unsigned char*)lds_raw;
    const int tid = threadIdx.x, lane = tid & 63, wave = __builtin_amdgcn_readfirstlane(tid >> 6), G = gridDim.x;
    unsigned char* ws = a.ws;
    float* SS = (float*)(ws + WS_SS); bf16* XB = (bf16*)(ws + WS_XB); bf16* ACT = (bf16*)(ws + WS_ACT);
    bf16* QKV = (bf16*)(ws + WS_QKV); bf16* Z = (bf16*)(ws + WS_Z); bf16* MIX = (bf16*)(ws + WS_MIX);
    float* X = a.out;

    volatile LAS unsigned* bst = (volatile LAS unsigned*)(lds + RING_BYTES);
    if (tid < 2) bst[tid] = 0u;
    unsigned* barw = (unsigned*)(ws + WS_CTL);
    if (blockIdx.x == 0) for (int w = tid; w < XCD_BAR_WORDS; w += NTHR) barw[w] = 0u;
    for (int rep = 0; rep < REP_PRO; ++rep) { prologue(a, lds, wave, lane, G); CG_SYNC(); }
    const XcdBarrier bar = xcd_barrier_post(barw, bst);
    for (int rep = 0; rep < XSYNC; ++rep) GRID_SYNC();

    for (int l = 0; l < DEPTH; ++l) {
        unsigned char* wl = ws + WS_W + (size_t)l * WL_SIZE;
        for (int part = 0; part < 3; ++part) {
            if (part != 1) {
                const bf16* Wi = (const bf16*)(wl + (part == 0 ? WL_FI1 : WL_FI2)); const bf16* Wo = (const bf16*)(wl + (part == 0 ? WL_FO1 : WL_FO2));
                for (int rep = 0; rep < REP_FFI; ++rep) {
                    pg8::Gemm g{lnd(XB), lnd(Wi), M, NFFI, DM}; pg8::StaticOrder S; S.init(M, NFFI, G, (int)blockIdx.x, REP_FFI_STREAM);
                    pg8::EpiSwiGLU E{lnd(ACT), DFF, lnd(SS)};
                    pg8::gemm_phase<pg8::EpiSwiGLU, pg8::StaticOrder, true, true>(lds, g, S, E);
                    GRID_SYNC();
                }
                {
                    pg8::Gemm g{lnd(ACT), lnd(Wo), M, DM, DFF}; pg8::StaticOrder S; S.init(M, DM, G, (int)blockIdx.x);
                    pg8::EpiResid E{lnd(XB), lnd(SS), 0.5f};
                    pg8::gemm_phase<pg8::EpiResid, pg8::StaticOrder, true, true>(lds, g, S, E);
                }
                GRID_SYNC();
            } else {
                for (int rep = 0; rep < REP_INP; ++rep) {
                    pg8::Gemm g{lnd(XB), lnd((const bf16*)(wl + WL_IN)), M, INW, DM}; pg8::StaticOrder S; S.init(M, INW, G, (int)blockIdx.x);
                    pg8::EpiInProj E{lnd(QKV), lnd(Z), lnd(SS), 0.125f * L2E};
                    pg8::gemm_phase<pg8::EpiInProj, pg8::StaticOrder, true, true>(lds, g, S, E);
                    GRID_SYNC();
                }
                for (int rep = 0; rep < REP_MIX; ++rep)
                for (int u = blockIdx.x; u < 512 + 1024; u += G) {
                    if (u < 512) { for (int r2 = 0; r2 < REP_ATT; ++r2) attn_unit(lds, u, lnd(QKV), lnd(MIX), lnd(a.in[6] + l * NHEADS)); }
                    else conv_unit(lds, u - 512, lnd(Z), lnd(MIX), lnd(a.in[7] + (size_t)l * CONVW * CCH), lnd(a.in[8] + l * CCH), lnd(a.in[9] + l * CCH), lnd(a.in[10] + l * CCH));
                }
                GRID_SYNC();
                {
                    pg8::Gemm g{lnd(MIX), lnd((const bf16*)(wl + WL_OUT)), M, DM, DM}; pg8::StaticOrder S; S.init(M, DM, G, (int)blockIdx.x);
                    pg8::EpiResid E{lnd(XB), lnd(SS), 1.0f};
                    pg8::gemm_phase<pg8::EpiResid, pg8::StaticOrder, true, true>(lds, g, S, E);
                }
                GRID_SYNC();
            }
        }
    }
    {
        const float* ssf = lnd(SS); const float* gf = a.in[15]; const bf16* xbf = lnd(XB);
        int lane = tid & 63; asm volatile("" : "+v"(lane));
        const int gw = blockIdx.x * NWAVES + wave, NGW = G * NWAVES;
        f32x4 gv[4];
#pragma unroll
        for (int q = 0; q < 2; ++q) { gv[2 * q] = *((const f32x4*)gf + 2 * (lane + 64 * q)); gv[2 * q + 1] = *((const f32x4*)gf + 2 * (lane + 64 * q) + 1); }
        for (int m = gw; m < M; m += NGW) {
            const f32x4 pp = *(const f32x4*)(ssf + (size_t)m * 16 + 4 * (lane & 3)); float sq = (pp[0] + pp[1]) + (pp[2] + pp[3]); sq += __shfl_xor(sq, 1); sq += __shfl_xor(sq, 2);
            const float rs = rsqrtf(sq * (1.0f / DM) + EPS);
#pragma unroll
            for (int q = 0; q < 2; ++q) { const v4u xv = *((const v4u*)(xbf + (size_t)m * DM) + lane + 64 * q);
                const f32x4 x0 = (f32x4){__builtin_bit_cast(float, xv.x << 16), __builtin_bit_cast(float, xv.x & 0xffff0000u), __builtin_bit_cast(float, xv.y << 16), __builtin_bit_cast(float, xv.y & 0xffff0000u)};
                const f32x4 x1 = (f32x4){__builtin_bit_cast(float, xv.z << 16), __builtin_bit_cast(float, xv.z & 0xffff0000u), __builtin_bit_cast(float, xv.w << 16), __builtin_bit_cast(float, xv.w & 0xffff0000u)};
                f32x4* o = (f32x4*)(X + (size_t)m * DM) + 2 * (lane + 64 * q);
                o[0] = x0 * rs * gv[2 * q]; o[1] = x1 * rs * gv[2 * q + 1]; } }
    }
}

extern "C" void kernel_launch(void* const* d_in, const int* in_sizes, int n_in, void* d_out, int out_size, void* d_ws, size_t ws_size, hipStream_t stream) {
    static int grid = 0;
    if (grid == 0) {
        if (n_in != 16 || in_sizes[0] != M * DM || out_size != M * DM || ws_size < WS_END) { fprintf(stderr, "kernel_launch: unexpected shapes / workspace (n_in %d, ws %zu, need %zu)\n", n_in, ws_size, (size_t)WS_END); grid = -1; return; }
        int dev = 0, cus = 0, per_cu = 0;
        (void)hipGetDevice(&dev); (void)hipDeviceGetAttribute(&cus, hipDeviceAttributeMultiprocessorCount, dev);
        if (hipFuncSetAttribute((const void*)fwd_mega, hipFuncAttributeMaxDynamicSharedMemorySize, LDS_BYTES) != hipSuccess) { fprintf(stderr, "kernel_launch: hipFuncSetAttribute failed\n"); grid = -1; return; }
        if (hipOccupancyMaxActiveBlocksPerMultiprocessor(&per_cu, (const void*)fwd_mega, NTHR, LDS_BYTES) != hipSuccess || per_cu < 1) { fprintf(stderr, "kernel_launch: occupancy query says %d\n", per_cu); per_cu = 1; }
        (void)hipGetLastError();
        grid = cus * 1;
    }
    if (grid < 0) return;
    Args a{};
    for (int i = 0; i < 16; ++i) a.in[i] = (const float*)d_in[i];
    a.out = (float*)d_out; a.ws = (unsigned char*)d_ws;
    void* args[] = {&a};
    hipError_t e = hipLaunchCooperativeKernel((const void*)fwd_mega, dim3(grid), dim3(NTHR), args, LDS_BYTES, stream);
    if (e != hipSuccess) fprintf(stderr, "cooperative launch failed: %s (grid %d)\n", hipGetErrorString(e), grid);
}
```

```cpp
#include <hip/hip_runtime.h>
#include <hip/hip_cooperative_groups.h>
#include <cstdio>
#include <cstdint>
namespace cg = cooperative_groups;
namespace pg8 {
#define PG8_LAS __attribute__((address_space(3)))
typedef unsigned short bf16_t;
typedef short bf16x8 __attribute__((ext_vector_type(8)));
typedef float f32x4 __attribute__((ext_vector_type(4)));
typedef unsigned u32x4 __attribute__((ext_vector_type(4)));
constexpr int BM = 256, BK = 64, HALF = 128, HTB = HALF * BK * 2  , STAGE_BYTES = 8 * HTB, NXCD = 8, WGM = 4;

__host__ __device__ __forceinline__ int lds_byte(int r, int c) { const int st = (r >> 4) * 2 + (c >> 5), rr = r & 15, cc = c & 31, ob = rr * 64 + cc * 2; return st * 1024 + (ob ^ (((ob >> 9) & 1) << 5)); }
__host__ __device__ __forceinline__ void stage_rc(int b, int& R, int& C) { const int st = b / 1024, sb = b % 1024, swz = sb ^ (((sb >> 9) & 1) << 5); R = (st >> 1) * 16 + swz / 64; C = (st & 1) * 32 + (swz % 64) / 2; }
__host__ __device__ __forceinline__ int perm32(int rho) { const int n = rho >> 4, i = rho & 15; return 8 * (i >> 2) + 4 * n + (i & 3); }

struct Unit { int pm, pn; };
struct Gemm { const bf16_t* A; const bf16_t* Bt; int M, N, K; };

struct StaticOrder {
    int nM, nN, nwg, G, c, rep;
    __host__ __device__ void init(int M, int N, int G_, int c_, int rep_ = 1) { nM = M / BM; nN = N / BM; nwg = nM * nN; G = G_; c = c_; rep = rep_; }
    __host__ __device__ bool next(int i, Unit& u) const {
        const int R = (nwg + G - 1) / G; if (i >= R * rep) return false; i = i % R;
        const long L = (long)i * G + c; if (L >= nwg) return false;
        int wgid = (int)L; { const int q = nwg / NXCD, r = nwg % NXCD, xcd = wgid % NXCD, off = wgid / NXCD; wgid = (xcd < r ? xcd * (q + 1) : r * (q + 1) + (xcd - r) * q) + off; }
        const int nig = WGM * nN, gid = wgid / nig, fm = gid * WGM, gsz = (nM - fm) < WGM ? (nM - fm) : WGM;
        u.pm = fm + ((wgid % nig) % gsz); u.pn = (wgid % nig) / gsz; return true;
    }
    __device__ __forceinline__ void a_ready(const Unit&) const {}
    __device__ __forceinline__ void done(const Unit&) const {}
};

__device__ __forceinline__ unsigned cvt_pk_bf16(float lo, float hi) { unsigned r; asm volatile("v_cvt_pk_bf16_f32 %0, %1, %2" : "=v"(r) : "v"(lo), "v"(hi)); return r; }
typedef float f32x2 __attribute__((ext_vector_type(2)));
constexpr float RMS_EPS = 1e-6f, LOG2E = 1.4426950408889634f;
__device__ __forceinline__ float sigm(float g) { return __builtin_amdgcn_rcpf(1.0f + __builtin_amdgcn_exp2f(-LOG2E * g)); }
#define PG8_GAS __attribute__((address_space(1)))
typedef PG8_GAS u32x4 g_u32x4; typedef PG8_GAS const u32x4 gc_u32x4; typedef PG8_GAS const f32x4 gc_f32x4; typedef PG8_GAS float g_f32;
__device__ __forceinline__ void xsum_fq8(float (&v)[2][4]) {
#pragma unroll
    for (int step = 16; step <= 32; step <<= 1) {
        float t[2][4];
#pragma unroll
        for (int a = 0; a < 2; ++a)
#pragma unroll
            for (int m = 0; m < 4; ++m) t[a][m] = __shfl_xor(v[a][m], step);
        asm volatile("" : "+v"(t[0][0]), "+v"(t[0][1]), "+v"(t[0][2]), "+v"(t[0][3]), "+v"(t[1][0]), "+v"(t[1][1]), "+v"(t[1][2]), "+v"(t[1][3]));
#pragma unroll
        for (int a = 0; a < 2; ++a)
#pragma unroll
            for (int m = 0; m < 4; ++m) v[a][m] += t[a][m];
    }
}
__device__ __forceinline__ void row_rstd8(const float* ssp, int row0, int fq, float (&rs)[2][4]) {
    f32x4 p[2][4];
#pragma unroll
    for (int ai = 0; ai < 2; ++ai)
#pragma unroll
        for (int m = 0; m < 4; ++m) p[ai][m] = *(gc_f32x4*)(ssp + (size_t)(row0 + ai * HALF + m * 16) * 16 + 4 * fq);
    asm volatile("" : "+v"(p[0][0]), "+v"(p[0][1]), "+v"(p[0][2]), "+v"(p[0][3]), "+v"(p[1][0]), "+v"(p[1][1]), "+v"(p[1][2]), "+v"(p[1][3]));
#pragma unroll
    for (int ai = 0; ai < 2; ++ai)
#pragma unroll
        for (int m = 0; m < 4; ++m) rs[ai][m] = (p[ai][m][0] + p[ai][m][1]) + (p[ai][m][2] + p[ai][m][3]);
    xsum_fq8(rs);
#pragma unroll
    for (int ai = 0; ai < 2; ++ai)
#pragma unroll
        for (int m = 0; m < 4; ++m) rs[ai][m] = rsqrtf(rs[ai][m] * (1.0f / 1024.0f) + RMS_EPS);
}
struct EpiSwiGLU {
    static constexpr bool PERM = true, AFTER_DRAIN = false;
    bf16_t* O; int ldc; const float* ss;
    __device__ __forceinline__ void operator()(const f32x4 (&acc)[2][2][4][2], const Unit& u, int wr, int wc, int fr, int fq) const {
        const int row0 = u.pm * BM + wr * 64 + fr, col0 = u.pn * HALF + wc * 32 + 8 * fq;
        float rsv[2][4]; row_rstd8(ss, row0, fq, rsv);
#pragma unroll
        for (int ai = 0; ai < 2; ++ai)
#pragma unroll
            for (int m = 0; m < 4; ++m) { const int row = row0 + ai * HALF + m * 16; const float rs = rsv[ai][m];
                const float c1 = -LOG2E * rs, rs2 = rs * rs;
                float o[8];
#pragma unroll
                for (int n = 0; n < 2; ++n)
#pragma unroll
                    for (int e = 0; e < 4; ++e) { const float g = acc[ai][0][m][n][e], up = acc[ai][1][m][n][e];
                        const float r = __builtin_amdgcn_rcpf(1.0f + __builtin_amdgcn_exp2f(g * c1)); o[4 * n + e] = (g * up) * (r * rs2); }
                u32x4 w; w.x = cvt_pk_bf16(o[0], o[1]); w.y = cvt_pk_bf16(o[2], o[3]); w.z = cvt_pk_bf16(o[4], o[5]); w.w = cvt_pk_bf16(o[6], o[7]);
                *(g_u32x4*)(O + (size_t)row * ldc + col0) = w; }
    }
};
struct EpiInProj {
    static constexpr bool PERM = true, AFTER_DRAIN = false;
    bf16_t* QKV; bf16_t* Z; const float* ss; float qscale;
    __device__ __forceinline__ void operator()(const f32x4 (&acc)[2][2][4][2], const Unit& u, int wr, int wc, int fr, int fq) const {
        const int row0 = u.pm * BM + wr * 64 + fr;
        float rsv[2][4]; row_rstd8(ss, row0, fq, rsv);
        if (u.pn < 3) {
            const float sc = u.pn < 2 ? qscale : 1.0f; const int col0 = u.pn * BM + wc * 32 + 8 * fq;
#pragma unroll
            for (int ai = 0; ai < 2; ++ai)
#pragma unroll
                for (int m = 0; m < 4; ++m) { const int row = row0 + ai * HALF + m * 16; const float rs = rsv[ai][m] * sc;
#pragma unroll
                    for (int bj = 0; bj < 2; ++bj) { const f32x4 v0 = acc[ai][bj][m][0] * rs, v1 = acc[ai][bj][m][1] * rs;
                        u32x4 w; w.x = cvt_pk_bf16(v0[0], v0[1]); w.y = cvt_pk_bf16(v0[2], v0[3]); w.z = cvt_pk_bf16(v1[0], v1[1]); w.w = cvt_pk_bf16(v1[2], v1[3]);
                        *(g_u32x4*)(QKV + (size_t)row * 768 + col0 + bj * HALF) = w; } }
        } else {
            const int col0 = (u.pn - 3) * HALF + wc * 32 + 8 * fq;
#pragma unroll
            for (int ai = 0; ai < 2; ++ai)
#pragma unroll
                for (int m = 0; m < 4; ++m) { const int row = row0 + ai * HALF + m * 16; const float rs = rsv[ai][m];
                    float o[8];
#pragma unroll
                    for (int n = 0; n < 2; ++n)
#pragma unroll
                        for (int e = 0; e < 4; ++e) { const float a = acc[ai][0][m][n][e] * rs, g = acc[ai][1][m][n][e] * rs; o[4 * n + e] = a * sigm(g); }
                    u32x4 w; w.x = cvt_pk_bf16(o[0], o[1]); w.y = cvt_pk_bf16(o[2], o[3]); w.z = cvt_pk_bf16(o[4], o[5]); w.w = cvt_pk_bf16(o[6], o[7]);
                    *(g_u32x4*)(Z + (size_t)row * 512 + col0) = w; }
        }
    }
};
struct EpiResid {
    static constexpr bool PERM = true, AFTER_DRAIN = false;
    bf16_t* xb; float* ssacc; float scale;
    __device__ __forceinline__ void operator()(const f32x4 (&acc)[2][2][4][2], const Unit& u, int wr, int wc, int fr, int fq) const {
        const int row0 = u.pm * BM + wr * 64 + fr, col0 = u.pn * BM + wc * 32 + 8 * fq;
        float sqv[2][4];
#pragma unroll
        for (int ai = 0; ai < 2; ++ai)
#pragma unroll
            for (int m = 0; m < 4; ++m) { const int row = row0 + ai * HALF + m * 16; bf16_t* p = xb + (size_t)row * 1024 + col0; float sq = 0.f; (void)row;
                const u32x4 xv0 = *(gc_u32x4*)p, xv1 = *(gc_u32x4*)(p + HALF);
#pragma unroll
                for (int bj = 0; bj < 2; ++bj) { const u32x4 xv = bj ? xv1 : xv0;
                    const f32x4 x0 = (f32x4){__builtin_bit_cast(float, xv.x << 16), __builtin_bit_cast(float, xv.x & 0xffff0000u), __builtin_bit_cast(float, xv.y << 16), __builtin_bit_cast(float, xv.y & 0xffff0000u)};
                    const f32x4 x1 = (f32x4){__builtin_bit_cast(float, xv.z << 16), __builtin_bit_cast(float, xv.z & 0xffff0000u), __builtin_bit_cast(float, xv.w << 16), __builtin_bit_cast(float, xv.w & 0xffff0000u)};
                    const f32x4 o0 = x0 + acc[ai][bj][m][0] * scale, o1 = x1 + acc[ai][bj][m][1] * scale;
                    u32x4 w; w.x = cvt_pk_bf16(o0[0], o0[1]); w.y = cvt_pk_bf16(o0[2], o0[3]); w.z = cvt_pk_bf16(o1[0], o1[1]); w.w = cvt_pk_bf16(o1[2], o1[3]);
                    *(g_u32x4*)(p + bj * HALF) = w;
                    sq += (o0[0] * o0[0] + o0[1] * o0[1]) + (o0[2] * o0[2] + o0[3] * o0[3]) + (o1[0] * o1[0] + o1[1] * o1[1]) + (o1[2] * o1[2] + o1[3] * o1[3]); }
                sqv[ai][m] = sq;
                asm volatile("" ::: "memory"); }
        xsum_fq8(sqv);
        if (fq == 0) {
#pragma unroll
            for (int ai = 0; ai < 2; ++ai)
#pragma unroll
                for (int m = 0; m < 4; ++m) *(g_f32*)(ssacc + (size_t)(row0 + ai * HALF + m * 16) * 16 + u.pn * 4 + wc) = sqv[ai][m]; }
    }
};

template <class Epi, class Sched, bool ALIGN_EPI = false, bool SP2 = false>
__device__ __forceinline__ void gemm_phase(PG8_LAS unsigned char* lds, const Gemm g, const Sched& S, const Epi& E) {
    int tid_ = threadIdx.x; asm volatile("" : "+v"(tid_));
    const int tid = tid_, wid = __builtin_amdgcn_readfirstlane(tid >> 6), lane = tid & 63, wr = wid >> 2, wc = wid & 3, fr = lane & 15, fq = lane >> 4;
    const int K = g.K, nt = K / BK;
    unsigned voffA[2], voffB[2];
#pragma unroll
    for (int i = 0; i < 2; ++i) { int R, C; stage_rc(tid * 16 + i * 8192, R, C); const int Rb = Epi::PERM ? ((R & ~31) + perm32(R & 31)) : R;
        voffA[i] = (unsigned)(R * K + C) * 2u; voffB[i] = (unsigned)(Rb * K + C) * 2u; }
    const size_t kstep = (size_t)(BK * 2);
    const size_t hstep = (size_t)HALF * K * 2;
    const size_t tstep = 2 * hstep;
    const unsigned ldsw = (unsigned)wid * 1024u;
    const int aoff = lds_byte(wr * 64 + fr, fq * 8), boff = lds_byte(wc * 32 + fr, fq * 8);
#define PG8_SA(b, h) (((b) * 2 + (h)) * HTB)
#define PG8_SB(b, h) ((4 + (b) * 2 + (h)) * HTB)
#define PG8_STAGE(bufoff, gbase, voff) do { _Pragma("unroll") for (int _i = 0; _i < 2; ++_i) \
        __builtin_amdgcn_global_load_lds((const unsigned*)((const char*)(gbase) + (voff)[_i]), (PG8_LAS unsigned*)(lds + (bufoff) + ldsw + _i * 8192), 16, 0, 0); } while (0)
#define PG8_LDA(dst, b, h) do { _Pragma("unroll") for (int m = 0; m < 4; ++m) _Pragma("unroll") for (int k = 0; k < 2; ++k) dst[m][k] = *(const PG8_LAS bf16x8*)(lds + PG8_SA(b, h) + aoff + m * 2048 + k * 1024); } while (0)
#define PG8_LDB(dst, b, h) do { _Pragma("unroll") for (int n = 0; n < 2; ++n) _Pragma("unroll") for (int k = 0; k < 2; ++k) dst[n][k] = *(const PG8_LAS bf16x8*)(lds + PG8_SB(b, h) + boff + n * 2048 + k * 1024); } while (0)
#define PG8_MMA(ai, bj, At, Bt) do { __builtin_amdgcn_s_setprio(1); _Pragma("unroll") for (int m = 0; m < 4; ++m) _Pragma("unroll") for (int n = 0; n < 2; ++n) _Pragma("unroll") for (int k = 0; k < 2; ++k) \
        acc[ai][bj][m][n] = __builtin_amdgcn_mfma_f32_16x16x32_bf16(Bt[n][k], At[m][k], acc[ai][bj][m][n], 0, 0, 0); __builtin_amdgcn_s_setprio(0); } while (0)
#define PG8_WAIT_V(n) asm volatile("s_waitcnt vmcnt(" #n ")" ::: "memory")
#define PG8_WAIT_L(n) asm volatile("s_waitcnt lgkmcnt(" #n ")" ::: "memory")
#define PG8_BAR __builtin_amdgcn_s_barrier()
#define PG8_SCHED __builtin_amdgcn_sched_barrier(0)
    Unit cur, nxt; int ui = 0;
    if (!S.next(0, cur)) return;
    f32x4 acc[2][2][4][2];
#pragma unroll
    for (int a = 0; a < 2; ++a)
#pragma unroll
        for (int b = 0; b < 2; ++b)
#pragma unroll
            for (int m = 0; m < 4; ++m)
#pragma unroll
                for (int n = 0; n < 2; ++n) acc[a][b][m][n] = (f32x4){0.f, 0.f, 0.f, 0.f};
    bf16x8 At[4][2], B0[2][2], B1[2][2];
    const char* cA = (const char*)g.A + (size_t)cur.pm * tstep; const char* cB = (const char*)g.Bt + (size_t)cur.pn * tstep;
    S.a_ready(cur);
    if constexpr (SP2) {
        PG8_STAGE(PG8_SB(0, 0), cB, voffB); PG8_STAGE(PG8_SB(0, 1), cB + hstep, voffB); PG8_STAGE(PG8_SA(0, 0), cA, voffA); PG8_STAGE(PG8_SA(0, 1), cA + hstep, voffA);
        if (wr == 1) PG8_BAR;
        PG8_WAIT_V(2); PG8_BAR;
        PG8_STAGE(PG8_SB(1, 0), cB + kstep, voffB); PG8_STAGE(PG8_SA(1, 0), cA + kstep, voffA); PG8_STAGE(PG8_SB(1, 1), cB + hstep + kstep, voffB);
        PG8_WAIT_V(6); PG8_BAR;
    } else {
        PG8_STAGE(PG8_SB(0, 0), cB, voffB); PG8_STAGE(PG8_SA(0, 0), cA, voffA); PG8_STAGE(PG8_SB(0, 1), cB + hstep, voffB); PG8_STAGE(PG8_SA(0, 1), cA + hstep, voffA);
        if (wr == 1) PG8_BAR;
        PG8_WAIT_V(4); PG8_BAR;
        PG8_STAGE(PG8_SB(1, 0), cB + kstep, voffB); PG8_STAGE(PG8_SA(1, 0), cA + kstep, voffA); PG8_STAGE(PG8_SB(1, 1), cB + hstep + kstep, voffB);
        PG8_WAIT_V(6); PG8_BAR;
    }
    for (;;) {
        const bool has_next = S.next(ui + 1, nxt);
        const char* nA = has_next ? (const char*)g.A + (size_t)nxt.pm * tstep : cA; const char* nB = has_next ? (const char*)g.Bt + (size_t)nxt.pn * tstep : cB;
        for (int t = 0; t < nt; t += 2) {
            const bool last = (t == nt - 2);
            const char* a1 = cA + (size_t)(t + 1) * kstep;
            const char* a2 = last ? nA : cA + (size_t)(t + 2) * kstep; const char* b2 = last ? nB : cB + (size_t)(t + 2) * kstep;
            const char* a3 = a2 + kstep; const char* b3 = b2 + kstep;
            if (last && has_next) S.a_ready(nxt);
            if constexpr (SP2) {
            PG8_LDB(B0, 0, 0); PG8_LDB(B1, 0, 1); PG8_SCHED; PG8_LDA(At, 0, 0); PG8_STAGE(PG8_SA(1, 1), a1 + hstep, voffA);
            PG8_WAIT_V(8); PG8_WAIT_L(0); PG8_BAR; PG8_MMA(0, 0, At, B0); PG8_MMA(0, 1, At, B1); PG8_BAR; PG8_SCHED;
            PG8_LDA(At, 0, 1); PG8_STAGE(PG8_SB(0, 0), b2, voffB); PG8_STAGE(PG8_SB(0, 1), b2 + hstep, voffB); PG8_STAGE(PG8_SA(0, 0), a2, voffA);
            PG8_WAIT_V(8); PG8_WAIT_L(0); PG8_BAR; PG8_MMA(1, 0, At, B0); PG8_MMA(1, 1, At, B1); PG8_BAR; PG8_SCHED;
            PG8_LDB(B0, 1, 0); PG8_LDB(B1, 1, 1); PG8_SCHED; PG8_LDA(At, 1, 0); PG8_STAGE(PG8_SA(0, 1), a2 + hstep, voffA);
            PG8_WAIT_V(8); PG8_WAIT_L(0); PG8_BAR; PG8_MMA(0, 0, At, B0); PG8_MMA(0, 1, At, B1); PG8_BAR; PG8_SCHED;
            PG8_LDA(At, 1, 1); PG8_STAGE(PG8_SB(1, 0), b3, voffB); PG8_STAGE(PG8_SB(1, 1), b3 + hstep, voffB); PG8_STAGE(PG8_SA(1, 0), a3, voffA);
            PG8_WAIT_V(8); PG8_WAIT_L(0); PG8_BAR; PG8_MMA(1, 0, At, B0); PG8_MMA(1, 1, At, B1); PG8_BAR; PG8_SCHED;
            } else {
            PG8_LDB(B0, 0, 0); PG8_SCHED; PG8_LDA(At, 0, 0); PG8_STAGE(PG8_SA(1, 1), a1 + hstep, voffA);
            PG8_WAIT_L(8); PG8_BAR; PG8_WAIT_L(0); PG8_MMA(0, 0, At, B0); PG8_BAR; PG8_SCHED;
            PG8_LDB(B1, 0, 1); PG8_STAGE(PG8_SB(0, 0), b2, voffB);
            PG8_BAR; PG8_WAIT_L(0); PG8_MMA(0, 1, At, B1); PG8_BAR;
            PG8_LDA(At, 0, 1); PG8_STAGE(PG8_SA(0, 0), a2, voffA);
            PG8_BAR; PG8_WAIT_L(0); PG8_MMA(1, 0, At, B0); PG8_BAR; PG8_SCHED;
            PG8_STAGE(PG8_SB(0, 1), b2 + hstep, voffB);
            PG8_WAIT_V(6); PG8_BAR; PG8_MMA(1, 1, At, B1); PG8_BAR;
            PG8_LDB(B0, 1, 0); PG8_SCHED; PG8_LDA(At, 1, 0); PG8_STAGE(PG8_SA(0, 1), a2 + hstep, voffA);
            PG8_WAIT_L(8); PG8_BAR; PG8_WAIT_L(0); PG8_MMA(0, 0, At, B0); PG8_BAR; PG8_SCHED;
            PG8_LDB(B1, 1, 1); PG8_STAGE(PG8_SB(1, 0), b3, voffB);
            PG8_BAR; PG8_WAIT_L(0); PG8_MMA(0, 1, At, B1); PG8_BAR;
            PG8_LDA(At, 1, 1); PG8_STAGE(PG8_SA(1, 0), a3, voffA);
            PG8_BAR; PG8_WAIT_L(0); PG8_MMA(1, 0, At, B0); PG8_BAR; PG8_SCHED;
            PG8_STAGE(PG8_SB(1, 1), b3 + hstep, voffB);
            PG8_WAIT_V(6); PG8_BAR; PG8_MMA(1, 1, At, B1); PG8_BAR;
            }
        }
        if constexpr (ALIGN_EPI) { if (wr == 0) PG8_BAR; }
        if constexpr (!Epi::AFTER_DRAIN) { E(acc, cur, wr, wc, fr, fq); S.done(cur); }
        if (!has_next) break;
#pragma unroll
        for (int a = 0; a < 2; ++a)
#pragma unroll
            for (int b = 0; b < 2; ++b)
#pragma unroll
                for (int m = 0; m < 4; ++m)
#pragma unroll
                    for (int n = 0; n < 2; ++n) acc[a][b][m][n] = (f32x4){0.f, 0.f, 0.f, 0.f};
        cur = nxt; cA = nA; cB = nB; ++ui;
        if constexpr (ALIGN_EPI) { if (wr == 1) PG8_BAR; }
    }
    PG8_WAIT_V(0);
    if constexpr (!ALIGN_EPI) { if (wr == 0) PG8_BAR; }
    PG8_BAR;
    if constexpr (Epi::AFTER_DRAIN) { E.fused(acc, cur, wr, wc, fr, fq, lds, wid, lane); S.done(cur); }
#undef PG8_SA
#undef PG8_SB
#undef PG8_STAGE
#undef PG8_LDA
#undef PG8_LDB
#undef PG8_MMA
#undef PG8_WAIT_V
#undef PG8_WAIT_L
#undef PG8_BAR
#undef PG8_SCHED
}
}

constexpr int NWAVES = 8, NTHR = 512;
constexpr int BATCH = 8, SEQ = 4096, DM = 1024, DEPTH = 4, DFF = 2816, NFFI = 2 * DFF, INW = 1792, NHEADS = 8, CONVW = 31, CCH = 512;
constexpr int M = BATCH * SEQ;
constexpr float EPS = 1e-6f, L2E = 1.4426950408889634f;
constexpr size_t MiB = 1u << 20;
constexpr size_t WS_SS = 0;
constexpr size_t WS_CTL = 2 * MiB;
constexpr size_t WS_W = 4 * MiB;
constexpr size_t W_FFI = (size_t)NFFI * DM * 2, W_FFO = (size_t)DM * DFF * 2, W_IN = (size_t)INW * DM * 2, W_OUT = (size_t)DM * DM * 2;
constexpr size_t WL_FI1 = 0, WL_FO1 = WL_FI1 + W_FFI, WL_IN = WL_FO1 + W_FFO, WL_OUT = WL_IN + W_IN, WL_FI2 = WL_OUT + W_OUT, WL_FO2 = WL_FI2 + W_FFI, WL_SIZE = WL_FO2 + W_FFO;
constexpr size_t WS_XB = 160 * MiB;
constexpr size_t WS_ACT = 224 * MiB;
constexpr size_t WS_QKV = WS_ACT, WS_Z = WS_QKV + (size_t)M * 768 * 2, WS_MIX = WS_Z + (size_t)M * 512 * 2;
constexpr size_t WS_END = WS_ACT + (size_t)M * DFF * 2;
static_assert(WS_W + DEPTH * WL_SIZE <= WS_XB && WS_XB + (size_t)M * DM * 2 <= WS_ACT && WS_MIX + (size_t)M * DM * 2 <= WS_END, "d_ws map");
constexpr int RING_BYTES = 131072, LDS_BYTES = 147456;
constexpr int REP_PRO = 1, REP_MIX = 1, XSYNC = 0, REP_FFI = 1, REP_INP = 1, REP_FFI_STREAM = 1, REP_ATT = 1;

#define GAS __attribute__((address_space(1)))
#define LAS __attribute__((address_space(3)))
typedef unsigned short bf16;
typedef unsigned v4u __attribute__((ext_vector_type(4)));
typedef float f32x4 __attribute__((ext_vector_type(4)));
typedef float f32x2 __attribute__((ext_vector_type(2)));
typedef float f32x16 __attribute__((ext_vector_type(16)));
typedef short bf16x8 __attribute__((ext_vector_type(8)));
typedef short s16x4 __attribute__((ext_vector_type(4)));
#define LDS_WAIT() asm volatile("s_waitcnt lgkmcnt(0)" ::: "memory")
__device__ __forceinline__ unsigned f2bf(float f) { unsigned u = __builtin_bit_cast(unsigned, f); return (u + 0x7fffu + ((u >> 16) & 1u)) >> 16; }
__device__ __forceinline__ unsigned pk2(float lo, float hi) { return f2bf(lo) | (f2bf(hi) << 16); }
__device__ __forceinline__ unsigned cvtpk(float lo, float hi) { typedef __bf16 bf2 __attribute__((ext_vector_type(2))); f32x2 v = {lo, hi}; return __builtin_bit_cast(unsigned, __builtin_convertvector(v, bf2)); }
__device__ __forceinline__ float wave_sum(float v) {
#pragma unroll
    for (int o = 1; o < 64; o <<= 1) v += __shfl_xor(v, o);
    return v;
}

template <int MAP> __device__ __forceinline__ int colmap(int np) {
    if (MAP == 1) { const int pn = np >> 8, bj = (np >> 7) & 1, jj = np & 127; return bj * DFF + pn * 128 + jj; }
    if (MAP == 2) { if (np < 768) return np; const int r = np - 768, t = r >> 8, bj = (r >> 7) & 1, jj = r & 127; return 768 + bj * CCH + t * 128 + jj; }
    return np;
}
struct Args { const float* in[16]; float* out; unsigned char* ws; };

struct TItem { const float* src; const float* gain; bf16* dst; int N, K; };
__device__ __forceinline__ TItem titem(const Args& a, int it, int lane) {
    constexpr int I_FI = (DM / 64) * (NFFI / 32), I_FO = (DFF / 64) * (DM / 32), I_IN = (DM / 64) * (INW / 32), I_OUT = (DM / 64) * (DM / 32);
    constexpr int I_LAYER = 2 * I_FI + 2 * I_FO + I_IN + I_OUT;
    const int l = it / I_LAYER; int r = it % I_LAYER;
    unsigned char* wl = a.ws + WS_W + (size_t)l * WL_SIZE;
    const float* W; const float* gain; bf16* WT; int K, N, map;
    if (r < I_FI) { W = a.in[2] + (size_t)l * DM * NFFI; gain = a.in[1] + l * DM; WT = (bf16*)(wl + WL_FI1); K = DM; N = NFFI; map = 1; }
    else if ((r -= I_FI) < I_FI) { W = a.in[13] + (size_t)l * DM * NFFI; gain = a.in[12] + l * DM; WT = (bf16*)(wl + WL_FI2); K = DM; N = NFFI; map = 1; }
    else if ((r -= I_FI) < I_FO) { W = a.in[3] + (size_t)l * DFF * DM; gain = nullptr; WT = (bf16*)(wl + WL_FO1); K = DFF; N = DM; map = 0; }
    else if ((r -= I_FO) < I_FO) { W = a.in[14] + (size_t)l * DFF * DM; gain = nullptr; WT = (bf16*)(wl + WL_FO2); K = DFF; N = DM; map = 0; }
    else if ((r -= I_FO) < I_IN) { W = a.in[5] + (size_t)l * DM * INW; gain = a.in[4] + l * DM; WT = (bf16*)(wl + WL_IN); K = DM; N = INW; map = 2; }
    else { r -= I_IN; W = a.in[11] + (size_t)l * DM * DM; gain = nullptr; WT = (bf16*)(wl + WL_OUT); K = DM; N = DM; map = 0; }
    const int nblk = N / 32, kb = r / nblk, nb = r % nblk, k0 = 64 * kb, n0 = 32 * nb;
    const int ns = map == 1 ? colmap<1>(n0) : map == 2 ? colmap<2>(n0) : n0;
    TItem t; t.src = W + (size_t)(k0 + (lane >> 5)) * N + ns + (lane & 31); t.gain = gain ? gain + k0 + lane : nullptr;
    t.dst = WT + (size_t)(n0 + (lane >> 3)) * K + k0 + 8 * (lane & 7); t.N = N; t.K = K; return t;
}
__device__ __forceinline__ void titem_load(const TItem& t, float (&v)[32], float& gv) {
#pragma unroll
    for (int i = 0; i < 32; ++i) v[i] = __builtin_nontemporal_load(t.src + (size_t)(2 * i) * t.N);
    gv = t.gain ? *t.gain : 1.0f;
}
__device__ __forceinline__ void titem_store(const TItem& t, const float (&v)[32], float gv, LAS float* scr, int lane) {
#pragma unroll
    for (int i = 0; i < 32; ++i) { const float g0 = __builtin_bit_cast(float, __builtin_amdgcn_readlane(__builtin_bit_cast(int, gv), 2 * i)), g1 = __builtin_bit_cast(float, __builtin_amdgcn_readlane(__builtin_bit_cast(int, gv), 2 * i + 1));
        scr[(2 * i + (lane >> 5)) * 33 + (lane & 31)] = v[i] * ((lane >> 5) ? g1 : g0); }
    LDS_WAIT(); asm volatile("" ::: "memory");
    const int c = lane & 7;
#pragma unroll
    for (int j = 0; j < 4; ++j) { const int n = (lane >> 3) + 8 * j; const LAS float* s = scr + (8 * c) * 33 + n;
        v4u o; o.x = pk2(s[0 * 33], s[1 * 33]); o.y = pk2(s[2 * 33], s[3 * 33]); o.z = pk2(s[4 * 33], s[5 * 33]); o.w = pk2(s[6 * 33], s[7 * 33]);
        *(GAS v4u*)(t.dst + (size_t)(8 * j) * t.K) = o; }
    LDS_WAIT(); asm volatile("" ::: "memory");
}

__device__ __forceinline__ void prologue(const Args& a, LAS unsigned char* lds, int wave, int lane, int G) {
    asm volatile("" : "+v"(lane));
    LAS float* scr = (LAS float*)(lds + wave * 16384);
    const int gw = blockIdx.x * NWAVES + wave, NGW = G * NWAVES;
    constexpr int I_TOTAL = DEPTH * (2 * (DM / 64) * (NFFI / 32) + 2 * (DFF / 64) * (DM / 32) + (DM / 64) * (INW / 32) + (DM / 64) * (DM / 32));
    if (gw < I_TOTAL) {
        TItem cur = titem(a, gw, lane); float v[32], w[32]; float gv, gw2 = 1.0f;
        titem_load(cur, v, gv);
        for (int it = gw; it < I_TOTAL; it += NGW) {
            const int nx = it + NGW; const bool more = nx < I_TOTAL; TItem nxt = cur;
            if (more) { nxt = titem(a, nx, lane); titem_load(nxt, w, gw2); }
            titem_store(cur, v, gv, scr, lane);
            if (more) {
#pragma unroll
                for (int i = 0; i < 32; ++i) v[i] = w[i];
                gv = gw2; cur = nxt; }
        }
    }
    float* ss = (float*)(a.ws + WS_SS); bf16* XB = (bf16*)(a.ws + WS_XB);
    for (int m = gw; m < M; m += 2 * NGW) {
        const int m2 = (m + NGW < M) ? m + NGW : m;
        const GAS f32x4* xr = (const GAS f32x4*)(a.in[0] + (size_t)m * DM) + lane; const GAS f32x4* xr2 = (const GAS f32x4*)(a.in[0] + (size_t)m2 * DM) + lane;
        f32x4 v[4], w[4]; float s = 0.f, s2 = 0.f;
#pragma unroll
        for (int j = 0; j < 4; ++j) { v[j] = __builtin_nontemporal_load(xr + 64 * j); w[j] = __builtin_nontemporal_load(xr2 + 64 * j); }
#pragma unroll
        for (int j = 0; j < 4; ++j) { s += (v[j].x * v[j].x + v[j].y * v[j].y) + (v[j].z * v[j].z + v[j].w * v[j].w); s2 += (w[j].x * w[j].x + w[j].y * w[j].y) + (w[j].z * w[j].z + w[j].w * w[j].w); }
        s = wave_sum(s); s2 = wave_sum(s2);
        GAS unsigned long long* o8 = (GAS unsigned long long*)(XB + (size_t)m * DM) + lane; GAS unsigned long long* p8 = (GAS unsigned long long*)(XB + (size_t)m2 * DM) + lane;
#pragma unroll
        for (int j = 0; j < 4; ++j) { o8[64 * j] = (unsigned long long)pk2(v[j].x, v[j].y) | ((unsigned long long)pk2(v[j].z, v[j].w) << 32);
            p8[64 * j] = (unsigned long long)pk2(w[j].x, w[j].y) | ((unsigned long long)pk2(w[j].z, w[j].w) << 32); }
        if (lane < 16) { ss[(size_t)m * 16 + lane] = lane == 0 ? s : 0.f; ss[(size_t)m2 * 16 + lane] = lane == 0 ? s2 : 0.f; }
    }
}

constexpr int AT_ROWB = 144, AT_VOFF = 256 * AT_ROWB;
__device__ __forceinline__ s16x4 vtr(const LAS unsigned char* p) { return __builtin_bit_cast(s16x4, __builtin_amdgcn_ds_read_tr16_b64_v4i16((LAS s16x4*)p)); }
__device__ __forceinline__ void attn_unit(LAS unsigned char* lds, int unit, const bf16* QKV, bf16* MIX, const float* sinks_l) {
    int tid = threadIdx.x; asm volatile("" : "+v"(tid));
    const int lane_ = tid & 63, wid = __builtin_amdgcn_readfirstlane(tid >> 6);
    const int kvh = unit & 1, n = (unit >> 1) & 31, b = unit >> 6;
    const size_t tok0 = (size_t)b * SEQ + (size_t)n * 128;
    const int hg = kvh * 4 + (wid >> 1);
    bf16x8 qa[2][4];
#pragma unroll
    for (int ii = 0; ii < 2; ++ii) { const bf16* qp = QKV + (tok0 + 32 * (2 * (wid & 1) + ii) + (lane_ & 31)) * 768 + hg * 64 + (lane_ >> 5) * 8;
#pragma unroll
        for (int d0 = 0; d0 < 4; ++d0) qa[ii][d0] = *(const bf16x8*)(qp + d0 * 16); }
#pragma unroll
    for (int i = 0; i < 4; ++i) { const int idx = tid + NTHR * i, row = idx >> 3, ch = idx & 7;
        v4u kv = (v4u){0u, 0u, 0u, 0u}, vv = kv;
        if (n > 0 || row >= 128) { const bf16* src = QKV + (tok0 + row - 128) * 768 + 512 + kvh * 64 + ch * 8; kv = *(const v4u*)src; vv = *(const v4u*)(src + 128); }
        *(LAS v4u*)(lds + row * AT_ROWB + ch * 16) = kv; *(LAS v4u*)(lds + AT_VOFF + row * AT_ROWB + ch * 16) = vv; }
    __syncthreads();
    const float slope2 = __builtin_amdgcn_exp2f(-(float)(hg + 1)) * L2E, sink2 = sinks_l[hg] * L2E;
#pragma unroll
    for (int ii = 0; ii < 2; ++ii) {
        int lane = lane_; asm volatile("" : "+v"(lane));
        const int r32 = lane & 31, hi = lane >> 5;
        const int i = 2 * (wid & 1) + ii;
        bf16x8 qr[4];
#pragma unroll
        for (int d0 = 0; d0 < 4; ++d0) qr[d0] = ii ? qa[1][d0] : qa[0][d0];
        f32x16 S[5];
#pragma unroll
        for (int t = 0; t < 5; ++t) { const LAS unsigned char* kp = lds + (32 * (i + t) + r32) * AT_ROWB + hi * 16;
#pragma unroll
            for (int e = 0; e < 16; ++e) S[t][e] = 0.f;
#pragma unroll
            for (int d0 = 0; d0 < 4; ++d0) { const bf16x8 kf = *(const LAS bf16x8*)(kp + d0 * 32); S[t] = __builtin_amdgcn_mfma_f32_32x32x16_bf16(kf, qr[d0], S[t], 0, 0, 0); } }
        const int rb = r32 - 4 * hi + 128, tl = 32 * i + r32; const unsigned lim = (unsigned)(n > 0 ? 127 : (tl < 127 ? tl : 127));
        float mx = sink2;
        const float nrb = -slope2 * (float)rb;
        if (n > 0) {
#pragma unroll
            for (int t = 0; t < 5; ++t)
#pragma unroll
                for (int r = 0; r < 16; ++r) { const int cst = 32 * t + (r & 3) + 8 * (r >> 2);
                    float s = (S[t][r] + nrb) + slope2 * (float)cst;
                    if (t == 0) s = (rb - cst <= 127) ? s : -1e30f;
                    if (t == 4) s = (rb - cst >= 0) ? s : -1e30f;
                    S[t][r] = s; mx = fmaxf(mx, s); }
        } else {
#pragma unroll
            for (int t = 0; t < 5; ++t)
#pragma unroll
                for (int r = 0; r < 16; ++r) { const int cst = 32 * t + (r & 3) + 8 * (r >> 2); const int dist = rb - cst;
                    const float s = ((unsigned)dist <= lim) ? (S[t][r] + nrb) + slope2 * (float)cst : -1e30f; S[t][r] = s; mx = fmaxf(mx, s); }
        }
        mx = fmaxf(mx, __shfl_xor(mx, 32));
        float l = 0.f;
#pragma unroll
        for (int t = 0; t < 5; ++t)
#pragma unroll
            for (int r = 0; r < 16; ++r) { const float p = __builtin_amdgcn_exp2f(S[t][r] - mx); S[t][r] = p; l += p; }
        l += __shfl_xor(l, 32); l += __builtin_amdgcn_exp2f(sink2 - mx);
        const float inv = 1.0f / l;
        f32x16 o0, o1;
#pragma unroll
        for (int e = 0; e < 16; ++e) { o0[e] = 0.f; o1[e] = 0.f; }
#pragma unroll
        for (int t = 0; t < 5; ++t)
#pragma unroll
            for (int s = 0; s < 2; ++s) {
                v4u pw; pw.x = cvtpk(S[t][8 * s + 0] * inv, S[t][8 * s + 1] * inv); pw.y = cvtpk(S[t][8 * s + 2] * inv, S[t][8 * s + 3] * inv);
                pw.z = cvtpk(S[t][8 * s + 4] * inv, S[t][8 * s + 5] * inv); pw.w = cvtpk(S[t][8 * s + 6] * inv, S[t][8 * s + 7] * inv);
                const bf16x8 pa = __builtin_bit_cast(bf16x8, pw);
                const LAS unsigned char* vp = lds + AT_VOFF + (32 * (i + t) + 16 * s + 4 * hi + ((lane & 15) >> 2)) * AT_ROWB + (16 * ((lane >> 4) & 1) + 4 * (lane & 3)) * 2;
                const s16x4 l0 = vtr(vp), h0 = vtr(vp + 8 * AT_ROWB), l1 = vtr(vp + 64), h1 = vtr(vp + 8 * AT_ROWB + 64);
                const bf16x8 v0 = (bf16x8){l0[0], l0[1], l0[2], l0[3], h0[0], h0[1], h0[2], h0[3]}, v1 = (bf16x8){l1[0], l1[1], l1[2], l1[3], h1[0], h1[1], h1[2], h1[3]};
                o0 = __builtin_amdgcn_mfma_f32_32x32x16_bf16(pa, v0, o0, 0, 0, 0); o1 = __builtin_amdgcn_mfma_f32_32x32x16_bf16(pa, v1, o1, 0, 0, 0); }
        bf16* op = MIX + (tok0 + 32 * i) * 1024 + hg * 64 + r32;
#pragma unroll
        for (int r = 0; r < 16; ++r) { const int q = (r & 3) + 8 * (r >> 2) + 4 * hi; const unsigned w2 = cvtpk(o0[r], o1[r]); op[(size_t)q * 1024] = (bf16)(w2 & 0xffffu); op[(size_t)q * 1024 + 32] = (bf16)(w2 >> 16); }
    }
    __syncthreads();
}

constexpr int CV_YOFF = 62 * 1024;
__device__ __forceinline__ void conv_unit(LAS unsigned char* lds, int cu, const bf16* Z, bf16* MIX, const float* wdw, const float* bdw, const float* lng, const float* lnb) {
    int tid = threadIdx.x; asm volatile("" : "+v"(tid));
    const int lane = tid & 63, wid = __builtin_amdgcn_readfirstlane(tid >> 6);
    const int b = cu >> 7, t0 = (cu & 127) * 32; const size_t tokb = (size_t)b * SEQ;
#pragma unroll
    for (int i = 0; i < 8; ++i) { const int idx = tid + NTHR * i;
        if (idx < 62 * 64) { const int row = idx >> 6, ch = idx & 63, t = t0 - 30 + row; v4u v = (v4u){0u, 0u, 0u, 0u};
            if (t >= 0) v = *(const v4u*)(Z + (tokb + t) * CCH + ch * 8);
            *(LAS v4u*)(lds + row * 1024 + ch * 16) = v; } }
    const int c2 = tid & 255, half = __builtin_amdgcn_readfirstlane(tid >> 8);
    f32x2 w2[CONVW];
#pragma unroll
    for (int k = 0; k < CONVW; ++k) w2[k] = *(const f32x2*)(wdw + k * CCH + 2 * c2);
    const f32x2 bb = *(const f32x2*)(bdw + 2 * c2);
    __syncthreads();
    {
        f32x2 ac[16];
#pragma unroll
        for (int o = 0; o < 16; ++o) ac[o] = bb;
        const LAS unsigned char* zp = lds + (16 * half) * 1024 + c2 * 4;
#pragma unroll
        for (int jj = 0; jj < 46; ++jj) { const unsigned zz = *(const LAS unsigned*)(zp + jj * 1024);
            const f32x2 z2 = (f32x2){__builtin_bit_cast(float, zz << 16), __builtin_bit_cast(float, zz & 0xffff0000u)};
#pragma unroll
            for (int o = 0; o < 16; ++o) { const int k = jj - o; if (k >= 0 && k < CONVW) ac[o] += w2[k] * z2; } }
        LAS float* yp = (LAS float*)(lds + CV_YOFF) + (16 * half) * CCH + 2 * c2;
#pragma unroll
        for (int o = 0; o < 16; ++o) *(LAS f32x2*)(yp + o * CCH) = ac[o];
    }
    __syncthreads();
    {
        const f32x4 g0 = *(const f32x4*)(lng + lane * 8), g1 = *(const f32x4*)(lng + lane * 8 + 4), b0 = *(const f32x4*)(lnb + lane * 8), b1 = *(const f32x4*)(lnb + lane * 8 + 4);
        f32x4 v0[4], v1[4]; float red[4];
#pragma unroll
        for (int q = 0; q < 4; ++q) { const LAS float* yr = (const LAS float*)(lds + CV_YOFF) + (4 * wid + q) * CCH + lane * 8;
            v0[q] = *(const LAS f32x4*)yr; v1[q] = *(const LAS f32x4*)(yr + 4);
            red[q] = (v0[q].x + v0[q].y) + (v0[q].z + v0[q].w) + (v1[q].x + v1[q].y) + (v1[q].z + v1[q].w); }
#pragma unroll
        for (int o = 1; o < 64; o <<= 1) { float t[4];
#pragma unroll
            for (int q = 0; q < 4; ++q) t[q] = __shfl_xor(red[q], o);
            asm volatile("" : "+v"(t[0]), "+v"(t[1]), "+v"(t[2]), "+v"(t[3]));
#pragma unroll
            for (int q = 0; q < 4; ++q) red[q] += t[q]; }
#pragma unroll
        for (int q = 0; q < 4; ++q) { const float mean = red[q] * (1.0f / CCH); v0[q] = v0[q] - mean; v1[q] = v1[q] - mean;
            red[q] = (v0[q].x * v0[q].x + v0[q].y * v0[q].y) + (v0[q].z * v0[q].z + v0[q].w * v0[q].w) + (v1[q].x * v1[q].x + v1[q].y * v1[q].y) + (v1[q].z * v1[q].z + v1[q].w * v1[q].w); }
#pragma unroll
        for (int o = 1; o < 64; o <<= 1) { float t[4];
#pragma unroll
            for (int q = 0; q < 4; ++q) t[q] = __shfl_xor(red[q], o);
            asm volatile("" : "+v"(t[0]), "+v"(t[1]), "+v"(t[2]), "+v"(t[3]));
#pragma unroll
            for (int q = 0; q < 4; ++q) red[q] += t[q]; }
#pragma unroll
        for (int q = 0; q < 4; ++q) { const int tl = 4 * wid + q; const float rstd = rsqrtf(red[q] * (1.0f / CCH) + EPS);
            const f32x4 w0 = v0[q] * rstd * g0 + b0, w1 = v1[q] * rstd * g1 + b1;
            float y[8] = {w0.x, w0.y, w0.z, w0.w, w1.x, w1.y, w1.z, w1.w};
#pragma unroll
            for (int e = 0; e < 8; ++e) y[e] = y[e] * __builtin_amdgcn_rcpf(1.0f + __builtin_amdgcn_exp2f(-L2E * y[e]));
            v4u o; o.x = pk2(y[0], y[1]); o.y = pk2(y[2], y[3]); o.z = pk2(y[4], y[5]); o.w = pk2(y[6], y[7]);
            *(v4u*)(MIX + (tokb + t0 + tl) * 1024 + 512 + lane * 8) = o; }
    }
    __syncthreads();
}

typedef GAS unsigned gu32;
#define XB_TMO      128
#define XB_XCNT(j)  (256  + 64 * (j))
#define XB_XSUB(j)  (1280 + 64 * (j))
#define XB_XGEN(j)  (2304 + 64 * (j))
#define XB_TOP      3328
#define XB_TOPGEN   3392
#define XCD_BAR_WORDS 3456
#define XB_SPIN_CAP (1u << 18)

__device__ __forceinline__ unsigned xb_ld(unsigned* p)              { return __hip_atomic_load(p, __ATOMIC_RELAXED, __HIP_MEMORY_SCOPE_AGENT); }
__device__ __forceinline__ unsigned xb_add(unsigned* p, unsigned v) { return __hip_atomic_fetch_add(p, v, __ATOMIC_RELAXED, __HIP_MEMORY_SCOPE_AGENT); }
__device__ __forceinline__ unsigned xb_xcc_id() { return (unsigned)__builtin_amdgcn_s_getreg((3 << 11) | 20) & 0xFu; }
#define XB_SPIN(cond, bar) do { unsigned _sp = 0; while (cond) { __builtin_amdgcn_s_sleep(1); \
    if ((++_sp & 255u) == 0u) { if (xb_ld(&(bar)[XB_TMO])) break; if (_sp > XB_SPIN_CAP) { atomicAdd(&(bar)[XB_TMO], 1u); break; } } } } while (0)

struct XcdBarrier {
    unsigned* bar; unsigned x;
    volatile LAS unsigned* st;
};

__device__ __forceinline__ XcdBarrier xcd_barrier_post(unsigned* bar, volatile LAS unsigned* st) {
    XcdBarrier b; b.bar = bar; b.x = xb_xcc_id(); b.st = st;
    if (threadIdx.x == 0) (void)xb_add(&bar[XB_XCNT(b.x)], 1u);
    return b;
}
__device__ __forceinline__ void xcd_barrier_complete(unsigned* bar, unsigned x, unsigned& nloc, unsigned& nx) {
    const unsigned G = gridDim.x * gridDim.y * gridDim.z;
    unsigned sum, cnt, mine, sp = 0u;
    for (;;) {
        sum = 0u; cnt = 0u; mine = 0u;
#pragma unroll
        for (unsigned j = 0; j < 16; ++j) { const unsigned c = xb_ld(&bar[XB_XCNT(j)]); sum += c; cnt += (c > 0u) ? 1u : 0u; }
        if (sum == G) { mine = xb_ld(&bar[XB_XCNT(x)]); break; }
        __builtin_amdgcn_s_sleep(1);
        if ((++sp & 255u) == 0u) { if (xb_ld(&bar[XB_TMO])) break; if (sp > XB_SPIN_CAP) { atomicAdd(&bar[XB_TMO], 1u); break; } }
    }
    nloc = mine > 0u ? mine : 1u; nx = cnt > 0u ? cnt : 1u;
}

__device__ __forceinline__ void xcd_barrier(const XcdBarrier& b) {
    asm volatile("s_waitcnt vmcnt(0)" ::: "memory");
    __syncthreads();
    if (threadIdx.x == 0) {
        unsigned* bar = b.bar;
        __builtin_amdgcn_s_waitcnt(0);
        unsigned nloc = b.st[0], nx = b.st[1];
        if (nloc == 0u) { xcd_barrier_complete(bar, b.x, nloc, nx); b.st[0] = nloc; b.st[1] = nx; }
        const unsigned old = xb_add(&bar[XB_XSUB(b.x)], 1u);
        const unsigned gen = old / nloc;
        if (old + 1u == (gen + 1u) * nloc) {
            __builtin_amdgcn_fence(__ATOMIC_RELEASE, "agent");
            asm volatile("s_waitcnt vmcnt(0)" ::: "memory");
            const unsigned og = xb_add(&bar[XB_TOP], 1u);
            const unsigned tg = og / nx;
            if (og + 1u == (tg + 1u) * nx) xb_add(&bar[XB_TOPGEN], 1u);
            else XB_SPIN(xb_ld(&bar[XB_TOPGEN]) == tg, bar);
            __builtin_amdgcn_fence(__ATOMIC_ACQUIRE, "agent");
            xb_add(&bar[XB_XGEN(b.x)], 1u);
            asm volatile("s_waitcnt vmcnt(0)" ::: "memory");
        } else {
            XB_SPIN(xb_ld(&bar[XB_XGEN(b.x)]) == gen, bar);
            __builtin_amdgcn_fence(__ATOMIC_ACQUIRE, "agent");
            asm volatile("s_waitcnt vmcnt(0)" ::: "memory");
        }
    }
    __syncthreads();
}

template <class T> __device__ __forceinline__ T* lnd(T* p) { GAS T* g = (GAS T*)p; asm volatile("" : "+s"(g)); return (T*)g; }
#define GRID_SYNC() xcd_barrier(bar)
#define CG_SYNC() do { asm volatile("s_waitcnt vmcnt(0) lgkmcnt(0)" ::: "memory"); __syncthreads(); grid.sync(); \
    __builtin_amdgcn_fence(__ATOMIC_ACQUIRE, "agent"); asm volatile("s_waitcnt vmcnt(0)" ::: "memory"); __syncthreads(); } while (0)
__global__ void __launch_bounds__(NTHR, 2) fwd_mega(Args a) {
    extern __shared__ __attribute__((aligned(16))) unsigned char lds_raw[];
    cg::grid_group grid = cg::this_grid();
    LAS unsigned char* lds = (LAS unsigned char*)lds_raw;
    const int tid = threadIdx.x, lane = tid & 63, wave = __builtin_amdgcn_readfirstlane(tid >> 6), G = gridDim.x;
    unsigned char* ws = a.ws;
    float* SS = (float*)(ws + WS_SS); bf16* XB = (bf16*)(ws + WS_XB); bf16* ACT = (bf16*)(ws + WS_ACT);
    bf16* QKV = (bf16*)(ws + WS_QKV); bf16* Z = (bf16*)(ws + WS_Z); bf16* MIX = (bf16*)(ws + WS_MIX);
    float* X = a.out;

    volatile LAS unsigned* bst = (volatile LAS unsigned*)(lds + RING_BYTES);
    if (tid < 2) bst[tid] = 0u;
    unsigned* barw = (unsigned*)(ws + WS_CTL);
    if (blockIdx.x == 0) for (int w = tid; w < XCD_BAR_WORDS; w += NTHR) barw[w] = 0u;
    for (int rep = 0; rep < REP_PRO; ++rep) { prologue(a, lds, wave, lane, G); CG_SYNC(); }
    const XcdBarrier bar = xcd_barrier_post(barw, bst);
    for (int rep = 0; rep < XSYNC; ++rep) GRID_SYNC();

    for (int l = 0; l < DEPTH; ++l) {
        unsigned char* wl = ws + WS_W + (size_t)l * WL_SIZE;
        for (int part = 0; part < 3; ++part) {
            if (part != 1) {
                const bf16* Wi = (const bf16*)(wl + (part == 0 ? WL_FI1 : WL_FI2)); const bf16* Wo = (const bf16*)(wl + (part == 0 ? WL_FO1 : WL_FO2));
                for (int rep = 0; rep < REP_FFI; ++rep) {
                    pg8::Gemm g{lnd(XB), lnd(Wi), M, NFFI, DM}; pg8::StaticOrder S; S.init(M, NFFI, G, (int)blockIdx.x, REP_FFI_STREAM);
                    pg8::EpiSwiGLU E{lnd(ACT), DFF, lnd(SS)};
                    pg8::gemm_phase<pg8::EpiSwiGLU, pg8::StaticOrder, true, true>(lds, g, S, E);
                    GRID_SYNC();
                }
                {
                    pg8::Gemm g{lnd(ACT), lnd(Wo), M, DM, DFF}; pg8::StaticOrder S; S.init(M, DM, G, (int)blockIdx.x);
                    pg8::EpiResid E{lnd(XB), lnd(SS), 0.5f};
                    pg8::gemm_phase<pg8::EpiResid, pg8::StaticOrder, true, true>(lds, g, S, E);
                }
                GRID_SYNC();
            } else {
                for (int rep = 0; rep < REP_INP; ++rep) {
                    pg8::Gemm g{lnd(XB), lnd((const bf16*)(wl + WL_IN)), M, INW, DM}; pg8::StaticOrder S; S.init(M, INW, G, (int)blockIdx.x);
                    pg8::EpiInProj E{lnd(QKV), lnd(Z), lnd(SS), 0.125f * L2E};
                    pg8::gemm_phase<pg8::EpiInProj, pg8::StaticOrder, true, true>(lds, g, S, E);
                    GRID_SYNC();
                }
                for (int rep = 0; rep < REP_MIX; ++rep)
                for (int u = blockIdx.x; u < 512 + 1024; u += G) {
                    if (u < 512) { for (int r2 = 0; r2 < REP_ATT; ++r2) attn_unit(lds, u, lnd(QKV), lnd(MIX), lnd(a.in[6] + l * NHEADS)); }
                    else conv_unit(lds, u - 512, lnd(Z), lnd(MIX), lnd(a.in[7] + (size_t)l * CONVW * CCH), lnd(a.in[8] + l * CCH), lnd(a.in[9] + l * CCH), lnd(a.in[10] + l * CCH));
                }
                GRID_SYNC();
                {
                    pg8::Gemm g{lnd(MIX), lnd((const bf16*)(wl + WL_OUT)), M, DM, DM}; pg8::StaticOrder S; S.init(M, DM, G, (int)blockIdx.x);
                    pg8::EpiResid E{lnd(XB), lnd(SS), 1.0f};
                    pg8::gemm_phase<pg8::EpiResid, pg8::StaticOrder, true, true>(lds, g, S, E);
                }
                GRID_SYNC();
            }
        }
    }
    {
        const float* ssf = lnd(SS); const float* gf = a.in[15]; const bf16* xbf = lnd(XB);
        int lane = tid & 63; asm volatile("" : "+v"(lane));
        const int gw = blockIdx.x * NWAVES + wave, NGW = G * NWAVES;
        f32x4 gv[4];
#pragma unroll
        for (int q = 0; q < 2; ++q) { gv[2 * q] = *((const f32x4*)gf + 2 * (lane + 64 * q)); gv[2 * q + 1] = *((const f32x4*)gf + 2 * (lane + 64 * q) + 1); }
        for (int m = gw; m < M; m += NGW) {
            const f32x4 pp = *(const f32x4*)(ssf + (size_t)m * 16 + 4 * (lane & 3)); float sq = (pp[0] + pp[1]) + (pp[2] + pp[3]); sq += __shfl_xor(sq, 1); sq += __shfl_xor(sq, 2);
            const float rs = rsqrtf(sq * (1.0f / DM) + EPS);
#pragma unroll
            for (int q = 0; q < 2; ++q) { const v4u xv = *((const v4u*)(xbf + (size_t)m * DM) + lane + 64 * q);
                const f32x4 x0 = (f32x4){__builtin_bit_cast(float, xv.x << 16), __builtin_bit_cast(float, xv.x & 0xffff0000u), __builtin_bit_cast(float, xv.y << 16), __builtin_bit_cast(float, xv.y & 0xffff0000u)};
                const f32x4 x1 = (f32x4){__builtin_bit_cast(float, xv.z << 16), __builtin_bit_cast(float, xv.z & 0xffff0000u), __builtin_bit_cast(float, xv.w << 16), __builtin_bit_cast(float, xv.w & 0xffff0000u)};
                f32x4* o = (f32x4*)(X + (size_t)m * DM) + 2 * (lane + 64 * q);
                o[0] = x0 * rs * gv[2 * q]; o[1] = x1 * rs * gv[2 * q + 1]; } }
    }
}

extern "C" void kernel_launch(void* const* d_in, const int* in_sizes, int n_in, void* d_out, int out_size, void* d_ws, size_t ws_size, hipStream_t stream) {
    static int grid = 0;
    if (grid == 0) {
        if (n_in != 16 || in_sizes[0] != M * DM || out_size != M * DM || ws_size < WS_END) { fprintf(stderr, "kernel_launch: unexpected shapes / workspace (n_in %d, ws %zu, need %zu)\n", n_in, ws_size, (size_t)WS_END); grid = -1; return; }
        int dev = 0, cus = 0, per_cu = 0;
        (void)hipGetDevice(&dev); (void)hipDeviceGetAttribute(&cus, hipDeviceAttributeMultiprocessorCount, dev);
        if (hipFuncSetAttribute((const void*)fwd_mega, hipFuncAttributeMaxDynamicSharedMemorySize, LDS_BYTES) != hipSuccess) { fprintf(stderr, "kernel_launch: hipFuncSetAttribute failed\n"); grid = -1; return; }
        if (hipOccupancyMaxActiveBlocksPerMultiprocessor(&per_cu, (const void*)fwd_mega, NTHR, LDS_BYTES) != hipSuccess || per_cu < 1) { fprintf(stderr, "kernel_launch: occupancy query says %d\n", per_cu); per_cu = 1; }
        (void)hipGetLastError();
        grid = cus * 1;
    }
    if (grid < 0) return;
    Args a{};
    for (int i = 0; i < 16; ++i) a.in[i] = (const float*)d_in[i];
    a.out = (float*)d_out; a.ws = (unsigned char*)d_ws;
    void* args[] = {&a};
    hipError_t e = hipLaunchCooperativeKernel((const void*)fwd_mega, dim3(grid), dim3(NTHR), args, LDS_BYTES, stream);
    if (e != hipSuccess) fprintf(stderr, "cooperative launch failed: %s (grid %d)\n", hipGetErrorString(e), grid);
}
```
